# Optimizing an MI355X kernel written in HIP

```python
import jax, jax.numpy as jnp
from jax import lax
import numpy as np

D_MODEL = 2048
BATCH = 2
SEQ = 4096
DEPTH = 4

PLE_DIM = 256
EPS = 1e-6
CONV_CH = D_MODEL // 4
CONV_WIDTH = 31
GLA_HEADS = 4
GLA_DV = D_MODEL // 16
GLA_DK = GLA_DV // 2
GLA_GATE_RANK = 16
GLA_TAU = 16.0
GLA_CHUNK = 64
MOBA_HEADS = 8
MOBA_HD = D_MODEL // 16
MOBA_BLOCK = 256
MOBA_TOPK = 3
MOBA_Q_CHUNK = 64
N_BRANCH = 3
FFN_DIM = ((8 * D_MODEL // 3 + 255) // 256) * 256
FFN_CONV_WIDTH = 3
IN_SIZES = (2 * CONV_CH,
            GLA_HEADS * GLA_DK,
            GLA_HEADS * GLA_DK,
            GLA_HEADS * GLA_DV,
            GLA_HEADS * GLA_DV,
            GLA_GATE_RANK,
            MOBA_HEADS * MOBA_HD,
            MOBA_HEADS * MOBA_HD,
            MOBA_HEADS * MOBA_HD)
IN_COLS = sum(IN_SIZES)

kernel_name = "hybrid_conformer_gla_moba_block"


def rms_norm(x, g):
    xf = x.astype(jnp.float32)
    y = xf * lax.rsqrt(jnp.mean(xf * xf, axis=-1, keepdims=True) + EPS)
    return (y * g.astype(jnp.float32)).astype(x.dtype)


def layer_norm(x, g, b):
    xf = x.astype(jnp.float32)
    mu = jnp.mean(xf, axis=-1, keepdims=True)
    xc = xf - mu
    y = xc * lax.rsqrt(jnp.mean(xc * xc, axis=-1, keepdims=True) + EPS)
    return (y * g.astype(jnp.float32) + b.astype(jnp.float32)).astype(x.dtype)


def causal_dwconv(x, w):
    k_w = w.shape[0]
    s = x.shape[1]
    xp = jnp.pad(x, ((0, 0), (k_w - 1, 0), (0, 0)))
    out = xp[:, k_w - 1:k_w - 1 + s] * w[k_w - 1]
    for j in range(k_w - 1):
        out = out + xp[:, j:j + s] * w[j]
    return out


def conformer_conv_branch(z_glu, conv_w, conv_b, ln_g, ln_b, w_o):
    val, gate = jnp.split(z_glu, 2, axis=-1)
    a = val * jax.nn.sigmoid(gate)
    a = causal_dwconv(a, conv_w) + conv_b
    a = jax.nn.silu(layer_norm(a, ln_g, ln_b))
    return a @ w_o


def gla_branch(q, k, v, r, a_low, w_a2, b_a, norm_g, w_o):
    b_sz, s, _ = q.shape
    n_c = s // GLA_CHUNK
    q = q.reshape(b_sz, s, GLA_HEADS, GLA_DK) * (GLA_DK ** -0.5)
    k = k.reshape(b_sz, s, GLA_HEADS, GLA_DK)
    v = v.reshape(b_sz, s, GLA_HEADS, GLA_DV)
    log_a = jax.nn.log_sigmoid((a_low @ w_a2 + b_a).astype(jnp.float32)) / GLA_TAU
    log_a = log_a.reshape(b_sz, s, GLA_HEADS, GLA_DK)

    def to_chunks(t):
        return t.reshape(b_sz, n_c, GLA_CHUNK, GLA_HEADS, -1).transpose(1, 0, 3, 2, 4).astype(jnp.float32)

    tri = jnp.tril(jnp.ones((GLA_CHUNK, GLA_CHUNK), dtype=bool))

    def step(state, xs):
        qc, kc, vc, lac = xs
        bc = jnp.cumsum(lac, axis=2)
        inter = jnp.einsum('bhtd,bhde->bhte', qc * jnp.exp(bc), state)
        diff = bc[:, :, :, None, :] - bc[:, :, None, :, :]
        decay = jnp.exp(jnp.where(tri[None, None, :, :, None], diff, -jnp.inf))
        attn = jnp.einsum('bhtd,bhsd,bhtsd->bhts', qc, kc, decay)
        intra = jnp.einsum('bhts,bhse->bhte', attn, vc)
        b_last = bc[:, :, -1, :]
        k_dec = kc * jnp.exp(b_last[:, :, None, :] - bc)
        state = state * jnp.exp(b_last)[..., None] + jnp.einsum('bhsd,bhse->bhde', k_dec, vc)
        return state, inter + intra

    state0 = jnp.zeros((b_sz, GLA_HEADS, GLA_DK, GLA_DV), jnp.float32)
    _, o = lax.scan(step, state0, (to_chunks(q), to_chunks(k), to_chunks(v), to_chunks(log_a)))
    o = o.transpose(1, 0, 3, 2, 4).reshape(b_sz, s, GLA_HEADS, GLA_DV).astype(v.dtype)
    o = rms_norm(o, norm_g) * jax.nn.silu(r.reshape(b_sz, s, GLA_HEADS, GLA_DV))
    return o.reshape(b_sz, s, GLA_HEADS * GLA_DV) @ w_o


def moba_branch(q, k, v, q_norm_g, k_norm_g, w_o):
    b_sz, s, _ = q.shape
    q = rms_norm(q.reshape(b_sz, s, MOBA_HEADS, MOBA_HD), q_norm_g).transpose(0, 2, 1, 3)
    k = rms_norm(k.reshape(b_sz, s, MOBA_HEADS, MOBA_HD), k_norm_g).transpose(0, 2, 1, 3)
    v = v.reshape(b_sz, s, MOBA_HEADS, MOBA_HD).transpose(0, 2, 1, 3)
    s_pad = -(-s // MOBA_BLOCK) * MOBA_BLOCK
    pad = ((0, 0), (0, 0), (0, s_pad - s), (0, 0))
    q, k, v = jnp.pad(q, pad), jnp.pad(k, pad), jnp.pad(v, pad)
    n_blk = s_pad // MOBA_BLOCK
    top_k = min(MOBA_TOPK, n_blk)
    kb = k.reshape(b_sz, MOBA_HEADS, n_blk, MOBA_BLOCK, MOBA_HD)
    vb = v.reshape(b_sz, MOBA_HEADS, n_blk, MOBA_BLOCK, MOBA_HD)
    k_mean = jnp.mean(kb.astype(jnp.float32), axis=3)
    n_q = s_pad // MOBA_Q_CHUNK
    q_chunks = q.reshape(b_sz, MOBA_HEADS, n_q, MOBA_Q_CHUNK, MOBA_HD).transpose(2, 0, 1, 3, 4)
    b_idx = jnp.arange(b_sz)[:, None, None, None]
    h_idx = jnp.arange(MOBA_HEADS)[None, :, None, None]
    scale = MOBA_HD ** -0.5

    def chunk(args):
        c, qc = args
        q_pos = c * MOBA_Q_CHUNK + jnp.arange(MOBA_Q_CHUNK)
        q_blk = q_pos // MOBA_BLOCK
        blk_s = jnp.einsum('bhqd,bhnd->bhqn', qc.astype(jnp.float32), k_mean)
        past = jnp.arange(n_blk)[None, :] < q_blk[:, None]
        blk_s = jnp.where(past, blk_s, -jnp.inf)
        top_val, top_idx = lax.top_k(blk_s, top_k)
        sel_ok = jnp.isfinite(top_val)
        k_sel = kb[b_idx, h_idx, top_idx]
        v_sel = vb[b_idx, h_idx, top_idx]
        s_sel = jnp.einsum('bhqd,bhqjkd->bhqjk', qc, k_sel).astype(jnp.float32) * scale
        s_sel = jnp.where(sel_ok[..., None], s_sel, -jnp.inf)
        s_sel = s_sel.reshape(b_sz, MOBA_HEADS, MOBA_Q_CHUNK, top_k * MOBA_BLOCK)
        own_start = (c * MOBA_Q_CHUNK // MOBA_BLOCK) * MOBA_BLOCK
        k_own = lax.dynamic_slice_in_dim(k, own_start, MOBA_BLOCK, axis=2)
        v_own = lax.dynamic_slice_in_dim(v, own_start, MOBA_BLOCK, axis=2)
        s_own = jnp.einsum('bhqd,bhkd->bhqk', qc, k_own).astype(jnp.float32) * scale
        k_pos = own_start + jnp.arange(MOBA_BLOCK)
        s_own = jnp.where(k_pos[None, :] <= q_pos[:, None], s_own, -jnp.inf)
        probs = jax.nn.softmax(jnp.concatenate([s_sel, s_own], axis=-1), axis=-1).astype(v.dtype)
        p_sel = probs[..., :top_k * MOBA_BLOCK].reshape(b_sz, MOBA_HEADS, MOBA_Q_CHUNK, top_k, MOBA_BLOCK)
        p_own = probs[..., top_k * MOBA_BLOCK:]
        return (jnp.einsum('bhqjk,bhqjkd->bhqd', p_sel, v_sel)
                + jnp.einsum('bhqk,bhkd->bhqd', p_own, v_own))

    o = lax.map(chunk, (jnp.arange(n_q), q_chunks))
    o = o.transpose(1, 0, 3, 2, 4).reshape(b_sz, s_pad, MOBA_HEADS * MOBA_HD)[:, :s]
    return o @ w_o


def setup_inputs(seed: int = 0) -> dict:
    key = jax.random.key(seed)
    ks = jax.random.split(key, 32)
    L, D, F = DEPTH, D_MODEL, FFN_DIM

    def w(k, shape, fan_in):
        return jax.random.normal(k, shape, jnp.float32) * (fan_in ** -0.5)

    def gain(k, shape):
        return 1.0 + 0.05 * jax.random.normal(k, shape, jnp.float32)

    def bias(k, shape):
        return 0.01 * jax.random.normal(k, shape, jnp.float32)

    return {
        "x": jax.random.normal(ks[0], (BATCH, SEQ, D), jnp.float32),
        "p": jax.random.normal(ks[1], (DEPTH, BATCH, SEQ, PLE_DIM), jnp.float32),
        "norm_mix_g": gain(ks[2], (L, D)),
        "w_in": w(ks[3], (L, D, IN_COLS), D),
        "conv_w": w(ks[4], (L, CONV_WIDTH, CONV_CH), CONV_WIDTH),
        "conv_b": bias(ks[5], (L, CONV_CH)),
        "conv_ln_g": gain(ks[6], (L, CONV_CH)),
        "conv_ln_b": bias(ks[7], (L, CONV_CH)),
        "w_conv_out": w(ks[8], (L, CONV_CH, D), CONV_CH),
        "gla_w_a2": w(ks[9], (L, GLA_GATE_RANK, GLA_HEADS * GLA_DK), GLA_GATE_RANK),
        "gla_b_a": bias(ks[10], (L, GLA_HEADS * GLA_DK)),
        "gla_norm_g": gain(ks[11], (L, GLA_DV)),
        "w_gla_out": w(ks[12], (L, GLA_HEADS * GLA_DV, D), GLA_HEADS * GLA_DV),
        "moba_q_norm_g": gain(ks[13], (L, MOBA_HD)),
        "moba_k_norm_g": gain(ks[14], (L, MOBA_HD)),
        "w_moba_out": w(ks[15], (L, MOBA_HEADS * MOBA_HD, D), MOBA_HEADS * MOBA_HD),
        "w_gate": w(ks[16], (L, D, N_BRANCH * D), D),
        "b_gate": bias(ks[17], (L, N_BRANCH * D)),
        "w_out": w(ks[18], (L, D, D), D),
        "norm_ffn_g": gain(ks[19], (L, D)),
        "w_up": w(ks[20], (L, D, 2 * F), D),
        "ffn_conv_w": w(ks[21], (L, FFN_CONV_WIDTH, 2 * F), FFN_CONV_WIDTH),
        "w_down": w(ks[22], (L, F, D), F),
        "norm_ple_g": gain(ks[23], (L, D)),
        "w_ple_gate": w(ks[24], (L, D, D), D),
        "w_ple": w(ks[25], (L, PLE_DIM, D), PLE_DIM),
    }


def reference(x, p, norm_mix_g, w_in, conv_w, conv_b, conv_ln_g, conv_ln_b, w_conv_out,
              gla_w_a2, gla_b_a, gla_norm_g, w_gla_out, moba_q_norm_g, moba_k_norm_g, w_moba_out,
              w_gate, b_gate, w_out, norm_ffn_g, w_up, ffn_conv_w, w_down,
              norm_ple_g, w_ple_gate, w_ple):
    b_sz, s, d = x.shape
    offsets = np.cumsum(IN_SIZES)[:-1].tolist()
    for i in range(DEPTH):
        h = rms_norm(x, norm_mix_g[i])
        z = h @ w_in[i]
        z_glu, gq, gk, gv, gr, ga, mq, mk, mv = jnp.split(z, offsets, axis=-1)
        y_a = conformer_conv_branch(z_glu, conv_w[i], conv_b[i], conv_ln_g[i], conv_ln_b[i], w_conv_out[i])
        y_b = gla_branch(gq, gk, gv, gr, ga, gla_w_a2[i], gla_b_a[i], gla_norm_g[i], w_gla_out[i])
        y_c = moba_branch(mq, mk, mv, moba_q_norm_g[i], moba_k_norm_g[i], w_moba_out[i])
        gates = jax.nn.sigmoid(h @ w_gate[i] + b_gate[i]).reshape(b_sz, s, N_BRANCH, d)
        merged = gates[:, :, 0] * y_a + gates[:, :, 1] * y_b + gates[:, :, 2] * y_c
        x = x + merged @ w_out[i]
        h = rms_norm(x, norm_ffn_g[i])
        u = causal_dwconv(h @ w_up[i], ffn_conv_w[i])
        u_g, u_v = jnp.split(u, 2, axis=-1)
        x = x + (jax.nn.silu(u_g) * u_v) @ w_down[i]
        g = jax.nn.sigmoid(rms_norm(x, norm_ple_g[i]) @ w_ple_gate[i])
        x = x + g * (p[i] @ w_ple[i])
    return x
```

```cpp
#include <hip/hip_runtime.h>
#include <cstdio>
#include <cstdint>
namespace pg8 {
#define PG8_LAS __attribute__((address_space(3)))
typedef unsigned short bf16_t;
typedef short bf16x8 __attribute__((ext_vector_type(8)));
typedef float f32x4 __attribute__((ext_vector_type(4)));
typedef unsigned u32x4 __attribute__((ext_vector_type(4)));
constexpr int BM = 256, BK = 64, HALF = 128, HTB = HALF * BK * 2  , STAGE_BYTES = 8 * HTB, NXCD = 8, WGM = 8;

__host__ __device__ __forceinline__ int lds_byte(int r, int c) { const int st = (r >> 4) * 2 + (c >> 5), rr = r & 15, cc = c & 31, ob = rr * 64 + cc * 2; return st * 1024 + (ob ^ (((ob >> 9) & 1) << 5)); }
__host__ __device__ __forceinline__ void stage_rc(int b, int& R, int& C) { const int st = b / 1024, sb = b % 1024, swz = sb ^ (((sb >> 9) & 1) << 5); R = (st >> 1) * 16 + swz / 64; C = (st & 1) * 32 + (swz % 64) / 2; }
__host__ __device__ __forceinline__ int perm32(int rho) { const int n = rho >> 4, i = rho & 15; return 8 * (i >> 2) + 4 * n + (i & 3); }

struct Unit { int pm, pn; };
struct Gemm { const bf16_t* A; const bf16_t* Bt; int M, N, K; };

struct StaticOrder {
    int nM, nN, nwg, G, c;
    __host__ __device__ void init(int M, int N, int G_, int c_) { nM = M / BM; nN = N / BM; nwg = nM * nN; G = G_; c = c_; }
    __host__ __device__ __forceinline__ bool next(int i, Unit& u) const {
        const long L = (long)i * G + c; if (L >= nwg) return false;
        int wgid = (int)L; { const int q = nwg / NXCD, r = nwg % NXCD, xcd = wgid % NXCD, off = wgid / NXCD; wgid = (xcd < r ? xcd * (q + 1) : r * (q + 1) + (xcd - r) * q) + off; }
        const int nig = WGM * nN, gid = wgid / nig, fm = gid * WGM, gsz = (nM - fm) < WGM ? (nM - fm) : WGM;
        u.pm = fm + ((wgid % nig) % gsz); u.pn = (wgid % nig) / gsz; return true;
    }
    __device__ __forceinline__ void a_ready(const Unit&) const {}
    __device__ __forceinline__ void done(const Unit&) const {}
};

struct MixedOrder : StaticOrder {
    __host__ __device__ __forceinline__ bool next(int i, Unit& u) const { if (!StaticOrder::next(i, u)) return false;
        const int q = u.pn, h = q >> 1; u.pn = (q & 1) == 0 ? 22 + h : (h < 22 ? h : 46); return true; }
};
struct TailOrder {
    int nM, nN, nwg, first, per, c;
    __host__ __device__ void init(int M, int N, int first_, int per_, int c_) { nM = M / BM; nN = N / BM; nwg = nM * nN; first = first_; per = per_; c = c_; }
    __host__ __device__ __forceinline__ bool next(int i, Unit& u) const { if (c < first || i >= per) return false; const int id = per * (c - first) + i; if (id >= nwg) return false; u.pm = id / nN; u.pn = id - u.pm * nN; return true; }
    __device__ __forceinline__ void a_ready(const Unit&) const {}
    __device__ __forceinline__ void done(const Unit&) const {}
};

__device__ __forceinline__ unsigned cvt_pk_bf16(float lo, float hi) { unsigned r; asm volatile("v_cvt_pk_bf16_f32 %0, %1, %2" : "=v"(r) : "v"(lo), "v"(hi)); return r; }
typedef float f32x2 __attribute__((ext_vector_type(2)));
constexpr float RMS_EPS = 1e-6f;
__device__ __forceinline__ float sigm(float v) { return __builtin_amdgcn_rcpf(1.0f + __builtin_amdgcn_exp2f(-1.4426950408889634f * v)); }
__device__ __forceinline__ f32x4 sigm4(const f32x4 v) { const f32x4 t = v * -1.4426950408889634f; f32x4 e;
#pragma unroll
    for (int j = 0; j < 4; ++j) e[j] = __builtin_amdgcn_exp2f(t[j]);
    const f32x4 d = e + 1.0f; f32x4 r;
#pragma unroll
    for (int j = 0; j < 4; ++j) r[j] = __builtin_amdgcn_rcpf(d[j]);
    return r; }
__device__ __forceinline__ f32x4 sigm4s(const f32x4 v, const float inv_s) { const f32x4 t = v * -1.4426950408889634f; f32x4 e;
#pragma unroll
    for (int j = 0; j < 4; ++j) e[j] = __builtin_amdgcn_exp2f(t[j]);
    const f32x4 d = e * inv_s + inv_s; f32x4 r;
#pragma unroll
    for (int j = 0; j < 4; ++j) r[j] = __builtin_amdgcn_rcpf(d[j]);
    return r; }
__device__ __forceinline__ float bf_lo(unsigned w) { return __uint_as_float(w << 16); }
__device__ __forceinline__ float bf_hi(unsigned w) { return __uint_as_float(w & 0xffff0000u); }
__device__ __forceinline__ float row_rstd(const float* part, size_t row, int fq, float inv_k) {
    const f32x4 a = *(const f32x4*)(part + row * 32 + fq * 8), b = *(const f32x4*)(part + row * 32 + fq * 8 + 4);
    float s = ((a[0] + a[1]) + (a[2] + a[3])) + ((b[0] + b[1]) + (b[2] + b[3]));
    s += __shfl_xor(s, 16); s += __shfl_xor(s, 32);
    return __builtin_amdgcn_rsqf(s * inv_k + RMS_EPS);
}
__device__ __forceinline__ void row_rstd8(float (&rs)[2][4], const float* part, int row0, int fq, float inv_k) {
    f32x4 a[2][4], b[2][4];
#pragma unroll
    for (int ai = 0; ai < 2; ++ai)
#pragma unroll
        for (int m = 0; m < 4; ++m) { const float* p = part + (size_t)(row0 + ai * HALF + m * 16) * 32 + fq * 8; a[ai][m] = *(const f32x4*)p; b[ai][m] = *(const f32x4*)(p + 4); }
#pragma unroll
    for (int ai = 0; ai < 2; ++ai)
#pragma unroll
        for (int m = 0; m < 4; ++m) { float s = ((a[ai][m][0] + a[ai][m][1]) + (a[ai][m][2] + a[ai][m][3])) + ((b[ai][m][0] + b[ai][m][1]) + (b[ai][m][2] + b[ai][m][3]));
            s += __shfl_xor(s, 16); s += __shfl_xor(s, 32); rs[ai][m] = __builtin_amdgcn_rsqf(s * inv_k + RMS_EPS); }
}
__device__ __forceinline__ void row_rstd4(float (&rs)[4], const float* part, int rowb, int fq, float inv_k) {
    f32x4 a[4], b[4];
#pragma unroll
    for (int m = 0; m < 4; ++m) { const float* p = part + (size_t)(rowb + m * 16) * 32 + fq * 8; a[m] = *(const f32x4*)p; b[m] = *(const f32x4*)(p + 4); }
#pragma unroll
    for (int m = 0; m < 4; ++m) { float s = ((a[m][0] + a[m][1]) + (a[m][2] + a[m][3])) + ((b[m][0] + b[m][1]) + (b[m][2] + b[m][3]));
        s += __shfl_xor(s, 16); s += __shfl_xor(s, 32); rs[m] = __builtin_amdgcn_rsqf(s * inv_k + RMS_EPS); }
}
struct EpiZ {
    static constexpr bool PERM = true, AFTER_DRAIN = false, PERMA = false, SEGS = false;
    bf16_t* O; int ldc; const float* rowss; float inv_k; const float* bias; int sig_lo, sig_hi, ga_pn; float* ga;
    __device__ __forceinline__ void operator()(const f32x4 (&acc)[2][2][4][2], const Unit& u, int wr, int wc, int fr, int fq) const {
        const int row0 = u.pm * BM + wr * 64 + fr, col0 = u.pn * BM + wc * 32 + 8 * fq;
        float rs[2][4];
        if (rowss) row_rstd8(rs, rowss, row0, fq, inv_k);
        else {
#pragma unroll
            for (int ai = 0; ai < 2; ++ai)
#pragma unroll
                for (int m = 0; m < 4; ++m) rs[ai][m] = 1.0f; }
        if (u.pn == ga_pn) {
            if (wc == 0 && fq < 2) {
#pragma unroll
                for (int ai = 0; ai < 2; ++ai)
#pragma unroll
                    for (int m = 0; m < 4; ++m) { float* gp = ga + (size_t)(row0 + ai * HALF + m * 16) * 16 + 8 * fq;
                        *(f32x4*)gp = acc[ai][0][m][0] * rs[ai][m]; *(f32x4*)(gp + 4) = acc[ai][0][m][1] * rs[ai][m]; }
            }
            return;
        }
        const bool sg = (u.pn >= sig_lo) && (u.pn < sig_hi);
        f32x4 bv[2][2];
#pragma unroll
        for (int bj = 0; bj < 2; ++bj)
#pragma unroll
            for (int n = 0; n < 2; ++n) bv[bj][n] = sg ? *(const f32x4*)(bias + (col0 - sig_lo * BM) + bj * HALF + 4 * n) : (f32x4){0.f, 0.f, 0.f, 0.f};
#pragma unroll
        for (int ai = 0; ai < 2; ++ai)
#pragma unroll
            for (int m = 0; m < 4; ++m) { bf16_t* rowp = O + (size_t)(row0 + ai * HALF + m * 16) * ldc + col0; const float r = rs[ai][m];
#pragma unroll
                for (int bj = 0; bj < 2; ++bj) { f32x4 v0 = acc[ai][bj][m][0] * r + bv[bj][0], v1 = acc[ai][bj][m][1] * r + bv[bj][1];
                    if (sg) {
                        { v0 = sigm4(v0); v1 = sigm4(v1); } }
                    u32x4 w; w.x = cvt_pk_bf16(v0[0], v0[1]); w.y = cvt_pk_bf16(v0[2], v0[3]); w.z = cvt_pk_bf16(v1[0], v1[1]); w.w = cvt_pk_bf16(v1[2], v1[3]);
                    *(u32x4*)(rowp + bj * HALF) = w; } }
    }
};
struct EpiIn {
    static constexpr bool PERM = true, AFTER_DRAIN = false, PERMA = false, SEGS = false;
    bf16_t* Z; int ldc; bf16_t* aglu; const float* rowss; float inv_k; const float* bgate; float* ga; const float* qg; const float* kg; PG8_LAS float* xl; bf16_t* qkv; int seq; const PG8_LAS float* rt; const PG8_LAS int* slot;
    __device__ __forceinline__ void operator()(const f32x4 (&acc)[2][2][4][2], const Unit& u, int wr, int wc, int fr, int fq) const {
        const int row0 = u.pm * BM + wr * 64 + fr, col0 = u.pn * BM + wc * 32 + 8 * fq, pn = u.pn;
        float rs[2][4];
        { const PG8_LAS float* rp = rt + slot[u.pm] * BM + wr * 64 + fr;
#pragma unroll
          for (int ai = 0; ai < 2; ++ai)
#pragma unroll
              for (int m = 0; m < 4; ++m) rs[ai][m] = rp[ai * HALF + m * 16]; }
        if (pn == 46) {
            if (wc == 0 && fq < 2) {
#pragma unroll
                for (int ai = 0; ai < 2; ++ai)
#pragma unroll
                    for (int m = 0; m < 4; ++m) { float* gp = ga + (size_t)(row0 + ai * HALF + m * 16) * 16 + 8 * fq;
                        *(f32x4*)gp = acc[ai][0][m][0] * rs[ai][m]; *(f32x4*)(gp + 4) = acc[ai][0][m][1] * rs[ai][m]; }
            }
            return;
        }
        if (pn < 4) {
            const int ch0 = pn * HALF + wc * 32 + 8 * fq;
#pragma unroll
            for (int ai = 0; ai < 2; ++ai)
#pragma unroll
                for (int m = 0; m < 4; ++m) { const float r = rs[ai][m]; f32x4 a0 = acc[ai][0][m][0] * r, a1 = acc[ai][0][m][1] * r; const f32x4 g0 = acc[ai][1][m][0] * r, g1 = acc[ai][1][m][1] * r;
                    { a0 *= sigm4(g0); a1 *= sigm4(g1); }
                    u32x4 w; w.x = cvt_pk_bf16(a0[0], a0[1]); w.y = cvt_pk_bf16(a0[2], a0[3]); w.z = cvt_pk_bf16(a1[0], a1[1]); w.w = cvt_pk_bf16(a1[2], a1[3]);
                    *(u32x4*)(aglu + (size_t)(row0 + ai * HALF + m * 16) * 512 + ch0) = w; }
            return;
        }
        if (pn >= 10 && pn < 18) {
            const bool isk = pn >= 14;
#pragma unroll
            for (int ai = 0; ai < 2; ++ai)
#pragma unroll
                for (int m = 0; m < 4; ++m)
#pragma unroll
                    for (int bj = 0; bj < 2; ++bj) { const f32x4 a = acc[ai][bj][m][0], b = acc[ai][bj][m][1];
                        float s = ((a[0] * a[0] + a[1] * a[1]) + (a[2] * a[2] + a[3] * a[3])) + ((b[0] * b[0] + b[1] * b[1]) + (b[2] * b[2] + b[3] * b[3]));
                        s += __shfl_xor(s, 16); s += __shfl_xor(s, 32);
                        if (fq == 0) xl[(ai * HALF + wr * 64 + m * 16 + fr) * 8 + bj * 4 + wc] = s * (rs[ai][m] * rs[ai][m]); }
            asm volatile("s_waitcnt lgkmcnt(0)" ::: "memory"); __builtin_amdgcn_s_barrier(); asm volatile("" ::: "memory");
            const float* gp = (isk ? kg : qg) + wc * 32 + 8 * fq;
            const f32x4 gn0 = *(const f32x4*)gp, gn1 = *(const f32x4*)(gp + 4);
#pragma unroll
            for (int ai = 0; ai < 2; ++ai)
#pragma unroll
                for (int m = 0; m < 4; ++m) { const int rl = ai * HALF + wr * 64 + m * 16 + fr; const f32x4 p0 = *(const PG8_LAS f32x4*)(xl + rl * 8), p1 = *(const PG8_LAS f32x4*)(xl + rl * 8 + 4);
                    const float t0 = (p0[0] + p0[1]) + (p0[2] + p0[3]), t1 = (p1[0] + p1[1]) + (p1[2] + p1[3]);
                    const float r0 = __builtin_amdgcn_rsqf(t0 * (1.0f / 128.0f) + RMS_EPS) * rs[ai][m], r1 = __builtin_amdgcn_rsqf(t1 * (1.0f / 128.0f) + RMS_EPS) * rs[ai][m];
                    const int grow = row0 + ai * HALF + m * 16, bb = grow / seq, tt = grow - bb * seq;
                    bf16_t* rowp = qkv + ((size_t)((isk ? 1 : 0) * (2 * 8) + bb * 8 + 2 * (pn - (isk ? 14 : 10))) * seq + tt) * 128 + wc * 32 + 8 * fq;
#pragma unroll
                    for (int bj = 0; bj < 2; ++bj) { const float r = bj ? r1 : r0; const f32x4 v0 = acc[ai][bj][m][0] * r * gn0, v1 = acc[ai][bj][m][1] * r * gn1;
                        u32x4 w; w.x = cvt_pk_bf16(v0[0], v0[1]); w.y = cvt_pk_bf16(v0[2], v0[3]); w.z = cvt_pk_bf16(v1[0], v1[1]); w.w = cvt_pk_bf16(v1[2], v1[3]);
                        *(u32x4*)(rowp + (size_t)bj * seq * 128) = w; } }
            return;
        }
        if (pn >= 22) {
            unsigned char* g8 = (unsigned char*)Z + 580911104ll;
            f32x4 bv[2][2];
#pragma unroll
            for (int bj = 0; bj < 2; ++bj)
#pragma unroll
                for (int n = 0; n < 2; ++n) bv[bj][n] = *(const f32x4*)(bgate + (col0 - 22 * BM) + bj * HALF + 4 * n);
#pragma unroll
            for (int ai = 0; ai < 2; ++ai)
#pragma unroll
                for (int m = 0; m < 4; ++m) { const int grow = row0 + ai * HALF + m * 16; const float r = rs[ai][m];
#pragma unroll
                    for (int bj = 0; bj < 2; ++bj) { const f32x4 v0 = sigm4s(acc[ai][bj][m][0] * r + bv[bj][0], 1.0f / 255.0f), v1 = sigm4s(acc[ai][bj][m][1] * r + bv[bj][1], 1.0f / 255.0f);
                        unsigned w0 = 0u, w1 = 0u;
                        w0 = __builtin_amdgcn_cvt_pk_u8_f32(v0[0], 0, w0); w0 = __builtin_amdgcn_cvt_pk_u8_f32(v0[1], 1, w0); w0 = __builtin_amdgcn_cvt_pk_u8_f32(v0[2], 2, w0); w0 = __builtin_amdgcn_cvt_pk_u8_f32(v0[3], 3, w0);
                        w1 = __builtin_amdgcn_cvt_pk_u8_f32(v1[0], 0, w1); w1 = __builtin_amdgcn_cvt_pk_u8_f32(v1[1], 1, w1); w1 = __builtin_amdgcn_cvt_pk_u8_f32(v1[2], 2, w1); w1 = __builtin_amdgcn_cvt_pk_u8_f32(v1[3], 3, w1);
                        typedef unsigned u32x2g __attribute__((ext_vector_type(2)));
                        *(u32x2g*)(g8 + (size_t)grow * 6144 + (col0 - 22 * BM) + bj * HALF) = (u32x2g){w0, w1}; } }
            return;
        }
        const bool sg = false;
        f32x4 bv[2][2];
#pragma unroll
        for (int bj = 0; bj < 2; ++bj)
#pragma unroll
            for (int n = 0; n < 2; ++n) bv[bj][n] = sg ? *(const f32x4*)(bgate + (col0 - 22 * BM) + bj * HALF + 4 * n) : (f32x4){0.f, 0.f, 0.f, 0.f};
#pragma unroll
        for (int ai = 0; ai < 2; ++ai)
#pragma unroll
            for (int m = 0; m < 4; ++m) { const int grow = row0 + ai * HALF + m * 16, bb = grow / seq, tt = grow - bb * seq; const bool isv = pn >= 18 && pn < 22;
                bf16_t* rowp = isv ? qkv + ((size_t)(2 * (2 * 8) + bb * 8 + 2 * (pn - 18)) * seq + tt) * 128 + wc * 32 + 8 * fq : Z + (size_t)grow * ldc + col0; const size_t bjs = isv ? (size_t)seq * 128 : (size_t)HALF; const float r = rs[ai][m];
#pragma unroll
                for (int bj = 0; bj < 2; ++bj) { f32x4 v0 = acc[ai][bj][m][0] * r + bv[bj][0], v1 = acc[ai][bj][m][1] * r + bv[bj][1];
                    if (sg) {
                        { v0 = sigm4(v0); v1 = sigm4(v1); } }
                    u32x4 w; w.x = cvt_pk_bf16(v0[0], v0[1]); w.y = cvt_pk_bf16(v0[2], v0[3]); w.z = cvt_pk_bf16(v1[0], v1[1]); w.w = cvt_pk_bf16(v1[2], v1[3]);
                    *(u32x4*)(rowp + bj * bjs) = w; } }
    }
};
template <int CTRL, bool BC> __device__ __forceinline__ float dppf(float old, float src) { return __builtin_bit_cast(float, __builtin_amdgcn_update_dpp(__builtin_bit_cast(int, old), __builtin_bit_cast(int, src), CTRL, 0xf, 0xf, BC)); }
__device__ __forceinline__ f32x4 prev_row1(const f32x4 xm, const f32x4 xm1) { f32x4 r;
#pragma unroll
    for (int j = 0; j < 4; ++j) r[j] = dppf<0x111, false>(dppf<0x10F, true>(0.f, xm1[j]), xm[j]);
    return r; }
__device__ __forceinline__ f32x4 prev_row2(const f32x4 xm, const f32x4 xm1) { f32x4 r;
#pragma unroll
    for (int j = 0; j < 4; ++j) r[j] = dppf<0x112, false>(dppf<0x10E, true>(0.f, xm1[j]), xm[j]);
    return r; }
struct EpiFfn {
    static constexpr bool PERM = true, AFTER_DRAIN = false, PERMA = true, SEGS = false;
    bf16_t* A; int ff; const float* fw; float* edge; const PG8_LAS float* rt; const PG8_LAS int* slot; PG8_LAS float* hx;
    __device__ __forceinline__ void operator()(const f32x4 (&acc)[2][2][4][2], const Unit& u, int wr, int wc, int fr, int fq) const {
        typedef unsigned u32x2 __attribute__((ext_vector_type(2)));
        const int rowg = u.pm * BM + wr * 64, ch0 = u.pn * HALF + wc * 32 + 8 * fq, colt = u.pn * BM + wc * 32 + 8 * fq, coll = wc * 32 + 8 * fq; const int ff2 = 2 * ff;
        float rs[2][4];
        { const PG8_LAS float* rp = rt + slot[u.pm] * BM + wr * 64 + 4 * fr;
#pragma unroll
          for (int ai = 0; ai < 2; ++ai)
#pragma unroll
              for (int m = 0; m < 4; ++m) rs[ai][m] = rp[ai * HALF + m]; }
        if (fr == 15) {
#pragma unroll
            for (int n = 0; n < 2; ++n)
#pragma unroll
                for (int ai = 0; ai < 2; ++ai) { const int g = ai * 2 + wr;
                    const f32x4 g2 = acc[ai][0][2][n] * rs[ai][2], g3 = acc[ai][0][3][n] * rs[ai][3], v2 = acc[ai][1][2][n] * rs[ai][2], v3 = acc[ai][1][3][n] * rs[ai][3];
                    if (g < 3) { PG8_LAS float* hp = hx + (g * 2) * 256 + coll + 4 * n;
                        *(PG8_LAS f32x4*)hp = g2; *(PG8_LAS f32x4*)(hp + 128) = v2; *(PG8_LAS f32x4*)(hp + 256) = g3; *(PG8_LAS f32x4*)(hp + 256 + 128) = v3; }
                    else { float* ep = edge + (size_t)(u.pm * 4 + 3) * 4 * ff2 + colt + 4 * n;
                        *(f32x4*)(ep) = g2; *(f32x4*)(ep + HALF) = v2; *(f32x4*)(ep + (size_t)ff2) = g3; *(f32x4*)(ep + (size_t)ff2 + HALF) = v3; } }
        }
        if (fr == 0 && wr == 0) {
#pragma unroll
            for (int n = 0; n < 2; ++n) { float* ep = edge + (size_t)(u.pm * 4) * 4 * ff2 + colt + 4 * n;
                *(f32x4*)(ep + (size_t)2 * ff2) = acc[0][0][0][n] * rs[0][0]; *(f32x4*)(ep + (size_t)2 * ff2 + HALF) = acc[0][1][0][n] * rs[0][0];
                *(f32x4*)(ep + (size_t)3 * ff2) = acc[0][0][1][n] * rs[0][1]; *(f32x4*)(ep + (size_t)3 * ff2 + HALF) = acc[0][1][1][n] * rs[0][1]; }
        }
        asm volatile("s_waitcnt lgkmcnt(0)" ::: "memory"); __builtin_amdgcn_s_barrier(); asm volatile("" ::: "memory");
        u32x2 w0s[2][4];
#pragma unroll
        for (int n = 0; n < 2; ++n) {
            f32x4 wg[3], wv[3];
#pragma unroll
            for (int j = 0; j < 3; ++j) { wg[j] = *(const f32x4*)(fw + (size_t)j * ff2 + ch0 + 4 * n); wv[j] = *(const f32x4*)(fw + (size_t)j * ff2 + ff + ch0 + 4 * n); }
#pragma unroll
            for (int ai = 0; ai < 2; ++ai) { const int g = ai * 2 + wr;
                f32x4 xg[4], xv[4];
#pragma unroll
                for (int m = 0; m < 4; ++m) { xg[m] = acc[ai][0][m][n] * rs[ai][m]; xv[m] = acc[ai][1][m][n] * rs[ai][m]; }
                f32x4 pg2, pg3, pv2, pv3;
#pragma unroll
                for (int j = 0; j < 4; ++j) { pg2[j] = dppf<0x111, true>(0.f, xg[2][j]); pg3[j] = dppf<0x111, true>(0.f, xg[3][j]); pv2[j] = dppf<0x111, true>(0.f, xv[2][j]); pv3[j] = dppf<0x111, true>(0.f, xv[3][j]); }
                if (fr == 0 && g > 0) { const PG8_LAS float* hp = hx + ((g - 1) * 2) * 256 + coll + 4 * n;
                    pg2 = *(const PG8_LAS f32x4*)hp; pv2 = *(const PG8_LAS f32x4*)(hp + 128); pg3 = *(const PG8_LAS f32x4*)(hp + 256); pv3 = *(const PG8_LAS f32x4*)(hp + 256 + 128); }
#pragma unroll
                for (int m = 0; m < 4; ++m) {
                    const f32x4 g2 = m >= 2 ? xg[m - 2] : (m == 1 ? pg3 : pg2), g1 = m >= 1 ? xg[m - 1] : pg3;
                    const f32x4 v2 = m >= 2 ? xv[m - 2] : (m == 1 ? pv3 : pv2), v1 = m >= 1 ? xv[m - 1] : pv3;
                    const f32x4 ug = wg[0] * g2 + wg[1] * g1 + wg[2] * xg[m];
                    const f32x4 uv = wv[0] * v2 + wv[1] * v1 + wv[2] * xv[m];
                    const f32x4 aw = ug * sigm4(ug) * uv; u32x2 w; w.x = cvt_pk_bf16(aw[0], aw[1]); w.y = cvt_pk_bf16(aw[2], aw[3]);
                    if (n == 0) w0s[ai][m] = w;
                    else if (m >= 2 || fr > 0 || g > 0) *(u32x4*)(A + (size_t)(rowg + ai * HALF + 4 * fr + m) * ff + ch0) = (u32x4){w0s[ai][m].x, w0s[ai][m].y, w.x, w.y}; }
            }
        }
    }
};
template <int MODE> struct EpiMerge {
    static constexpr bool PERM = true, AFTER_DRAIN = false, PERMA = false, SEGS = false;
    const bf16_t* G; int ldg, gcol0; bf16_t* tmp; bf16_t* mrg; int ldt;
    __device__ __forceinline__ void operator()(const f32x4 (&acc)[2][2][4][2], const Unit& u, int wr, int wc, int fr, int fq) const {
        const int row0 = u.pm * BM + wr * 64 + fr, col0 = u.pn * BM + wc * 32 + 8 * fq;
#pragma unroll
        for (int ai = 0; ai < 2; ++ai) {
            u32x4 gw[4][2], tw[4][2];
#pragma unroll
            for (int m = 0; m < 4; ++m)
#pragma unroll
                for (int bj = 0; bj < 2; ++bj) { const size_t row = (size_t)(row0 + ai * HALF + m * 16); const int col = col0 + bj * HALF;
                    gw[m][bj] = *(const u32x4*)(G + row * ldg + gcol0 + col); if (MODE >= 1) tw[m][bj] = *(const u32x4*)(tmp + row * ldt + col); }
#pragma unroll
            for (int m = 0; m < 4; ++m)
#pragma unroll
                for (int bj = 0; bj < 2; ++bj) { const size_t row = (size_t)(row0 + ai * HALF + m * 16); const int col = col0 + bj * HALF; const u32x4 g = gw[m][bj];
                    f32x4 v0 = acc[ai][bj][m][0] * (f32x4){bf_lo(g.x), bf_hi(g.x), bf_lo(g.y), bf_hi(g.y)};
                    f32x4 v1 = acc[ai][bj][m][1] * (f32x4){bf_lo(g.z), bf_hi(g.z), bf_lo(g.w), bf_hi(g.w)};
                    if (MODE >= 1) { const u32x4 t = tw[m][bj]; v0 += (f32x4){bf_lo(t.x), bf_hi(t.x), bf_lo(t.y), bf_hi(t.y)}; v1 += (f32x4){bf_lo(t.z), bf_hi(t.z), bf_lo(t.w), bf_hi(t.w)}; }
                    u32x4 w; w.x = cvt_pk_bf16(v0[0], v0[1]); w.y = cvt_pk_bf16(v0[2], v0[3]); w.z = cvt_pk_bf16(v1[0], v1[1]); w.w = cvt_pk_bf16(v1[2], v1[3]);
                    if (MODE <= 1) *(u32x4*)(tmp + row * ldt + col) = w; else *(u32x4*)(mrg + row * ldt + col) = w; }
        }
    }
};
struct EpiMerge3 {
    static constexpr bool PERM = true, AFTER_DRAIN = false, PERMA = false, SEGS = true; static constexpr int SEG1 = 8, SEG2 = 16;
    typedef unsigned u32x2q __attribute__((ext_vector_type(2)));
    const unsigned char* G; int ldg, gcol0; bf16_t* mrg; int ldt;
    static __device__ __forceinline__ f32x4 un4(const unsigned w) { return (f32x4){(float)(w & 255u), (float)((w >> 8) & 255u), (float)((w >> 16) & 255u), (float)(w >> 24)}; }
    static __device__ __forceinline__ f32x4 clamp4(f32x4 v) {
#pragma unroll
        for (int j = 0; j < 4; ++j) v[j] = fmaxf(v[j], 1e-9f);
        return v; }
    static __device__ __forceinline__ f32x4 rcp4(const f32x4 v) { f32x4 r;
#pragma unroll
        for (int j = 0; j < 4; ++j) r[j] = __builtin_amdgcn_rcpf(v[j]);
        return r; }
    __device__ __forceinline__ void rescale(f32x4 (&acc)[2][2][4][2], const Unit& u, int t, int wr, int wc, int fr, int fq) const {
        int row0 = u.pm * BM + wr * 64 + fr, col0 = u.pn * BM + wc * 32 + 8 * fq; const int bp = (t == SEG1) ? 0 : 1;
        asm volatile("" : "+v"(row0), "+v"(col0));
        const unsigned char* gb = G + (size_t)row0 * ldg + gcol0 + bp * 2048 + col0;
        u32x2q gp[2][4][2], gn[2][4][2];
#pragma unroll
        for (int ai = 0; ai < 2; ++ai)
#pragma unroll
            for (int m = 0; m < 4; ++m)
#pragma unroll
                for (int bj = 0; bj < 2; ++bj) { const unsigned char* p = gb + (size_t)(ai * HALF + m * 16) * ldg + bj * HALF; gp[ai][m][bj] = *(const u32x2q*)p; gn[ai][m][bj] = *(const u32x2q*)(p + 2048); }
#pragma unroll
        for (int ai = 0; ai < 2; ++ai)
#pragma unroll
            for (int m = 0; m < 4; ++m)
#pragma unroll
                for (int bj = 0; bj < 2; ++bj) {
                    acc[ai][bj][m][0] *= clamp4(un4(gp[ai][m][bj].x)) * rcp4(clamp4(un4(gn[ai][m][bj].x)));
                    acc[ai][bj][m][1] *= clamp4(un4(gp[ai][m][bj].y)) * rcp4(clamp4(un4(gn[ai][m][bj].y))); }
    }
    __device__ __forceinline__ void operator()(const f32x4 (&acc)[2][2][4][2], const Unit& u, int wr, int wc, int fr, int fq) const {
        const int row0 = u.pm * BM + wr * 64 + fr, col0 = u.pn * BM + wc * 32 + 8 * fq;
        u32x2q gw[2][4][2];
#pragma unroll
        for (int ai = 0; ai < 2; ++ai)
#pragma unroll
            for (int m = 0; m < 4; ++m)
#pragma unroll
                for (int bj = 0; bj < 2; ++bj) gw[ai][m][bj] = *(const u32x2q*)(G + (size_t)(row0 + ai * HALF + m * 16) * ldg + gcol0 + 2 * 2048 + col0 + bj * HALF);
#pragma unroll
        for (int ai = 0; ai < 2; ++ai)
#pragma unroll
            for (int m = 0; m < 4; ++m)
#pragma unroll
                for (int bj = 0; bj < 2; ++bj) { const f32x4 v0 = acc[ai][bj][m][0] * (clamp4(un4(gw[ai][m][bj].x)) * (1.0f / 255.0f)), v1 = acc[ai][bj][m][1] * (clamp4(un4(gw[ai][m][bj].y)) * (1.0f / 255.0f));
                    u32x4 w; w.x = cvt_pk_bf16(v0[0], v0[1]); w.y = cvt_pk_bf16(v0[2], v0[3]); w.z = cvt_pk_bf16(v1[0], v1[1]); w.w = cvt_pk_bf16(v1[2], v1[3]);
                    *(u32x4*)(mrg + (size_t)(row0 + ai * HALF + m * 16) * ldt + col0 + bj * HALF) = w; }
    }
};
template <bool PLE> struct EpiRes {
    static constexpr bool PERM = true, AFTER_DRAIN = false, PERMA = false, SEGS = false;
    const bf16_t* hi_in; bf16_t* hi_out; float* xout_f; float* rowss_out; const float* rowss_in; float inv_k; const bf16_t* pe; int ld;
    __device__ __forceinline__ void operator()(const f32x4 (&acc)[2][2][4][2], const Unit& u, int wr, int wc, int fr, int fq) const {
        const int row0 = u.pm * BM + wr * 64 + fr, col0 = u.pn * BM + wc * 32 + 8 * fq; constexpr int NB = PLE ? 2 : 4; constexpr bool PF = !PLE;
        float rs[2][4];
        if (PLE) { row_rstd4(rs[0], rowss_in, row0, fq, inv_k); row_rstd4(rs[1], rowss_in, row0 + HALF, fq, inv_k); }
        constexpr int NBT = 2 * (4 / NB);
        u32x4 xh[PF ? 2 : 1][NB][2], pw[PF ? 2 : 1][NB][2];
#define PG8_RES_LOAD(bi_, buf_) do { _Pragma("unroll") for (int mm = 0; mm < NB; ++mm) _Pragma("unroll") for (int bj = 0; bj < 2; ++bj) { \
            const size_t off = (size_t)(row0 + ((bi_) / (4 / NB)) * HALF + (NB * ((bi_) % (4 / NB)) + mm) * 16) * ld + col0 + bj * HALF; \
            xh[buf_][mm][bj] = *(const u32x4*)(hi_in + off); if (PLE) pw[buf_][mm][bj] = *(const u32x4*)(pe + off); } } while (0)
        if (PF) PG8_RES_LOAD(0, 0);
#pragma unroll
        for (int bi = 0; bi < NBT; ++bi) { const int ai = bi / (4 / NB), mh = bi % (4 / NB), buf = PF ? (bi & 1) : 0;
            if (PF) { if (bi + 1 < NBT) PG8_RES_LOAD(bi + 1, (bi + 1) & 1); } else PG8_RES_LOAD(bi, 0);
            __builtin_amdgcn_sched_barrier(0);
#pragma unroll
                for (int mm = 0; mm < NB; ++mm) { const int m = NB * mh + mm; const size_t row = (size_t)(row0 + ai * HALF + m * 16); float ss = 0.f;
                    const float r = PLE ? rs[ai][m] : 1.0f;
#pragma unroll
                    for (int bj = 0; bj < 2; ++bj) { const size_t off = row * ld + col0 + bj * HALF;
                        f32x4 v0 = acc[ai][bj][m][0], v1 = acc[ai][bj][m][1];
                        if (PLE) { const u32x4 p = pw[buf][mm][bj];
                            { v0 = sigm4(v0 * r); v1 = sigm4(v1 * r); }
                            v0 *= (f32x4){bf_lo(p.x), bf_hi(p.x), bf_lo(p.y), bf_hi(p.y)}; v1 *= (f32x4){bf_lo(p.z), bf_hi(p.z), bf_lo(p.w), bf_hi(p.w)}; }
                        const u32x4 h = xh[buf][mm][bj];
                        const f32x4 x0 = (f32x4){bf_lo(h.x), bf_hi(h.x), bf_lo(h.y), bf_hi(h.y)} + v0;
                        const f32x4 x1 = (f32x4){bf_lo(h.z), bf_hi(h.z), bf_lo(h.w), bf_hi(h.w)} + v1;
                        u32x4 w; w.x = cvt_pk_bf16(x0[0], x0[1]); w.y = cvt_pk_bf16(x0[2], x0[3]); w.z = cvt_pk_bf16(x1[0], x1[1]); w.w = cvt_pk_bf16(x1[2], x1[3]);
                        if (xout_f) { *(f32x4*)(xout_f + off) = x0; *(f32x4*)(xout_f + off + 4) = x1; }
                        else *(u32x4*)(hi_out + off) = w;
                        ss += (x0[0] * x0[0] + x0[1] * x0[1]) + (x0[2] * x0[2] + x0[3] * x0[3]) + (x1[0] * x1[0] + x1[1] * x1[1]) + (x1[2] * x1[2] + x1[3] * x1[3]); }
                    ss += __shfl_xor(ss, 16); ss += __shfl_xor(ss, 32);
                    if (fq == 0 && !xout_f) rowss_out[row * 32 + u.pn * 4 + wc] = ss; }
        }
#undef PG8_RES_LOAD
    }
};

template <class Epi, class Sched, bool ALIGN_EPI = false, bool SP2 = false>
__device__ __forceinline__ void gemm_phase(PG8_LAS unsigned char* lds, const Gemm g, const Sched& S, const Epi& E) {
    int tid_ = threadIdx.x; asm volatile("" : "+v"(tid_));
    const int tid = tid_, wid = __builtin_amdgcn_readfirstlane(tid >> 6), lane = tid & 63, wr = wid >> 2, wc = wid & 3, fr = lane & 15, fq = lane >> 4;
    const int K = g.K, nt = K / BK;
    unsigned voffA[2], voffB[2];
#pragma unroll
    for (int i = 0; i < 2; ++i) { int R, C; stage_rc(tid * 16 + i * 8192, R, C); const int Rb = Epi::PERM ? ((R & ~31) + perm32(R & 31)) : R;
        const int Ra = Epi::PERMA ? ((R & ~63) + 4 * (R & 15) + ((R >> 4) & 3)) : R;
        voffA[i] = (unsigned)(Ra * K + C) * 2u; voffB[i] = (unsigned)(Rb * K + C) * 2u; }
    const size_t kstep = (size_t)(BK * 2);
    const size_t hstep = (size_t)HALF * K * 2;
    const size_t tstep = 2 * hstep;
    const unsigned ldsw = (unsigned)wid * 1024u;
    const int aoff = lds_byte(wr * 64 + fr, fq * 8), boff = lds_byte(wc * 32 + fr, fq * 8);
#define PG8_SA(b, h) (((b) * 2 + (h)) * HTB)
#define PG8_SB(b, h) ((4 + (b) * 2 + (h)) * HTB)
#define PG8_STAGE(bufoff, gbase, voff) do { _Pragma("unroll") for (int _i = 0; _i < 2; ++_i) \
        __builtin_amdgcn_global_load_lds((const unsigned*)((const char*)(gbase) + (voff)[_i]), (PG8_LAS unsigned*)(lds + (bufoff) + ldsw + _i * 8192), 16, 0, 0); } while (0)
#define PG8_LDA(dst, b, h) do { _Pragma("unroll") for (int m = 0; m < 4; ++m) _Pragma("unroll") for (int k = 0; k < 2; ++k) dst[m][k] = *(const PG8_LAS bf16x8*)(lds + PG8_SA(b, h) + aoff + m * 2048 + k * 1024); } while (0)
#define PG8_LDB(dst, b, h) do { _Pragma("unroll") for (int n = 0; n < 2; ++n) _Pragma("unroll") for (int k = 0; k < 2; ++k) dst[n][k] = *(const PG8_LAS bf16x8*)(lds + PG8_SB(b, h) + boff + n * 2048 + k * 1024); } while (0)
#define PG8_MMA(ai, bj, At, Bt) do { __builtin_amdgcn_s_setprio(1); _Pragma("unroll") for (int m = 0; m < 4; ++m) _Pragma("unroll") for (int n = 0; n < 2; ++n) _Pragma("unroll") for (int k = 0; k < 2; ++k) \
        acc[ai][bj][m][n] = __builtin_amdgcn_mfma_f32_16x16x32_bf16(Bt[n][k], At[m][k], acc[ai][bj][m][n], 0, 0, 0); __builtin_amdgcn_s_setprio(0); } while (0)
#define PG8_WAIT_V(n) asm volatile("s_waitcnt vmcnt(" #n ")" ::: "memory")
#define PG8_WAIT_L(n) asm volatile("s_waitcnt lgkmcnt(" #n ")" ::: "memory")
#define PG8_BAR __builtin_amdgcn_s_barrier()
#define PG8_SCHED __builtin_amdgcn_sched_barrier(0)
    Unit cur, nxt; int ui = 0;
    if (!S.next(0, cur)) return;
    f32x4 acc[2][2][4][2];
#pragma unroll
    for (int a = 0; a < 2; ++a)
#pragma unroll
        for (int b = 0; b < 2; ++b)
#pragma unroll
            for (int m = 0; m < 4; ++m)
#pragma unroll
                for (int n = 0; n < 2; ++n) acc[a][b][m][n] = (f32x4){0.f, 0.f, 0.f, 0.f};
    bf16x8 At[4][2], B0[2][2], B1[2][2];
    const char* cA = (const char*)g.A + (size_t)cur.pm * tstep; const char* cB = (const char*)g.Bt + (size_t)cur.pn * tstep;
    S.a_ready(cur);
    if constexpr (SP2) {
        PG8_STAGE(PG8_SB(0, 0), cB, voffB); PG8_STAGE(PG8_SB(0, 1), cB + hstep, voffB); PG8_STAGE(PG8_SA(0, 0), cA, voffA); PG8_STAGE(PG8_SA(0, 1), cA + hstep, voffA);
        PG8_STAGE(PG8_SB(1, 0), cB + kstep, voffB); PG8_STAGE(PG8_SA(1, 0), cA + kstep, voffA); PG8_STAGE(PG8_SB(1, 1), cB + hstep + kstep, voffB);
        if (wr == 1) PG8_BAR;
        PG8_WAIT_V(8); PG8_BAR;
        PG8_WAIT_V(6); PG8_BAR;
    } else {
        PG8_STAGE(PG8_SB(0, 0), cB, voffB); PG8_STAGE(PG8_SA(0, 0), cA, voffA); PG8_STAGE(PG8_SB(0, 1), cB + hstep, voffB); PG8_STAGE(PG8_SA(0, 1), cA + hstep, voffA);
        if (wr == 1) PG8_BAR;
        PG8_WAIT_V(4); PG8_BAR;
        PG8_STAGE(PG8_SB(1, 0), cB + kstep, voffB); PG8_STAGE(PG8_SA(1, 0), cA + kstep, voffA); PG8_STAGE(PG8_SB(1, 1), cB + hstep + kstep, voffB);
        PG8_WAIT_V(6); PG8_BAR;
    }
    for (;;) {
        const bool has_next = S.next(ui + 1, nxt);
        const char* nA = has_next ? (const char*)g.A + (size_t)nxt.pm * tstep : cA + (size_t)(nt - 2) * kstep; const char* nB = has_next ? (const char*)g.Bt + (size_t)nxt.pn * tstep : cB + (size_t)(nt - 2) * kstep;
        for (int seg = 0; seg < (Epi::SEGS ? 3 : 1); ++seg) {
        int tb = 0, te = nt; if constexpr (Epi::SEGS) { tb = seg == 0 ? 0 : (seg == 1 ? Epi::SEG1 : Epi::SEG2); te = seg == 0 ? Epi::SEG1 : (seg == 1 ? Epi::SEG2 : nt); if (seg) E.rescale(acc, cur, tb, wr, wc, fr, fq); }
        for (int t = tb; t < te; t += 2) {
            const bool last = (t == nt - 2);
            const char* a1 = cA + (size_t)(t + 1) * kstep;
            const char* a2 = last ? nA : cA + (size_t)(t + 2) * kstep; const char* b2 = last ? nB : cB + (size_t)(t + 2) * kstep;
            const char* a3 = a2 + kstep; const char* b3 = b2 + kstep;
            if (last && has_next) S.a_ready(nxt);
            if constexpr (SP2) {
            PG8_LDB(B0, 0, 0); PG8_LDB(B1, 0, 1); PG8_SCHED; PG8_LDA(At, 0, 0); PG8_STAGE(PG8_SA(1, 1), a1 + hstep, voffA);
            PG8_WAIT_V(8); PG8_WAIT_L(0); PG8_BAR; PG8_MMA(0, 0, At, B0); PG8_MMA(0, 1, At, B1); PG8_BAR; PG8_SCHED;
            PG8_LDA(At, 0, 1); PG8_STAGE(PG8_SB(0, 0), b2, voffB); PG8_STAGE(PG8_SB(0, 1), b2 + hstep, voffB); PG8_STAGE(PG8_SA(0, 0), a2, voffA);
            PG8_WAIT_V(8); PG8_WAIT_L(0); PG8_BAR; PG8_MMA(1, 0, At, B0); PG8_MMA(1, 1, At, B1); PG8_BAR; PG8_SCHED;
            PG8_LDB(B0, 1, 0); PG8_LDB(B1, 1, 1); PG8_SCHED; PG8_LDA(At, 1, 0); PG8_STAGE(PG8_SA(0, 1), a2 + hstep, voffA);
            PG8_WAIT_V(8); PG8_WAIT_L(0); PG8_BAR; PG8_MMA(0, 0, At, B0); PG8_MMA(0, 1, At, B1); PG8_BAR; PG8_SCHED;
            PG8_LDA(At, 1, 1); PG8_STAGE(PG8_SB(1, 0), b3, voffB); PG8_STAGE(PG8_SB(1, 1), b3 + hstep, voffB); PG8_STAGE(PG8_SA(1, 0), a3, voffA);
            PG8_WAIT_V(8); PG8_WAIT_L(0); PG8_BAR; PG8_MMA(1, 0, At, B0); PG8_MMA(1, 1, At, B1); PG8_BAR; PG8_SCHED;
            } else {
            PG8_LDB(B0, 0, 0); PG8_SCHED; PG8_LDA(At, 0, 0); PG8_STAGE(PG8_SA(1, 1), a1 + hstep, voffA);
            PG8_WAIT_L(8); PG8_BAR; PG8_WAIT_L(0); PG8_MMA(0, 0, At, B0); PG8_BAR; PG8_SCHED;
            PG8_LDB(B1, 0, 1); PG8_STAGE(PG8_SB(0, 0), b2, voffB);
            PG8_BAR; PG8_WAIT_L(0); PG8_MMA(0, 1, At, B1); PG8_BAR;
            PG8_LDA(At, 0, 1); PG8_STAGE(PG8_SA(0, 0), a2, voffA);
            PG8_BAR; PG8_WAIT_L(0); PG8_MMA(1, 0, At, B0); PG8_BAR; PG8_SCHED;
            PG8_STAGE(PG8_SB(0, 1), b2 + hstep, voffB);
            PG8_WAIT_V(6); PG8_BAR; PG8_MMA(1, 1, At, B1); PG8_BAR;
            PG8_LDB(B0, 1, 0); PG8_SCHED; PG8_LDA(At, 1, 0); PG8_STAGE(PG8_SA(0, 1), a2 + hstep, voffA);
            PG8_WAIT_L(8); PG8_BAR; PG8_WAIT_L(0); PG8_MMA(0, 0, At, B0); PG8_BAR; PG8_SCHED;
            PG8_LDB(B1, 1, 1); PG8_STAGE(PG8_SB(1, 0), b3, voffB);
            PG8_BAR; PG8_WAIT_L(0); PG8_MMA(0, 1, At, B1); PG8_BAR;
            PG8_LDA(At, 1, 1); PG8_STAGE(PG8_SA(1, 0), a3, voffA);
            PG8_BAR; PG8_WAIT_L(0); PG8_MMA(1, 0, At, B0); PG8_BAR; PG8_SCHED;
            PG8_STAGE(PG8_SB(1, 1), b3 + hstep, voffB);
            PG8_WAIT_V(6); PG8_BAR; PG8_MMA(1, 1, At, B1); PG8_BAR;
            }
        }
        }
        if constexpr (ALIGN_EPI) { if (wr == 0) PG8_BAR; }
        if constexpr (!Epi::AFTER_DRAIN) { E(acc, cur, wr, wc, fr, fq); S.done(cur); }
        if (!has_next) break;
#pragma unroll
        for (int a = 0; a < 2; ++a)
#pragma unroll
            for (int b = 0; b < 2; ++b)
#pragma unroll
                for (int m = 0; m < 4; ++m)
#pragma unroll
                    for (int n = 0; n < 2; ++n) acc[a][b][m][n] = (f32x4){0.f, 0.f, 0.f, 0.f};
        cur = nxt; cA = nA; cB = nB; ++ui;
        if constexpr (ALIGN_EPI) { if (wr == 1) PG8_BAR; }
    }
    PG8_WAIT_V(0);
    if constexpr (!ALIGN_EPI) { if (wr == 0) PG8_BAR; }
    PG8_BAR;
    if constexpr (Epi::AFTER_DRAIN) { E.fused(acc, cur, wr, wc, fr, fq, lds, wid, lane); S.done(cur); }
#undef PG8_SA
#undef PG8_SB
#undef PG8_STAGE
#undef PG8_LDA
#undef PG8_LDB
#undef PG8_MMA
#undef PG8_WAIT_V
#undef PG8_WAIT_L
#undef PG8_BAR
#undef PG8_SCHED
}
}
namespace moba {
typedef unsigned short bf16;
typedef short bf16x8 __attribute__((ext_vector_type(8)));
typedef short s16x4 __attribute__((ext_vector_type(4)));
typedef float f32x16 __attribute__((ext_vector_type(16)));
typedef float f32x4 __attribute__((ext_vector_type(4)));
typedef unsigned u32x4 __attribute__((ext_vector_type(4)));
constexpr int D = 128, NW = 8, QBLK = 32, KVBLK = 64, QB = NW * QBLK;
constexpr int SHM_V = KVBLK * D * 2, SHM_K = KVBLK * D * 2;
constexpr int LDS_BYTES = 2 * SHM_V + 2 * SHM_K + NW * 64 * 4;
constexpr float SCALE = 0.08838834764831845f, THR = 8.f;
constexpr int KMH = 2 * 8 * 16 * 128;
#define KSWZ(row, colB) ((row) * 256 + ((colB) ^ (((row) & 7) << 4)))
#define SBAR() __builtin_amdgcn_sched_barrier(0)
__device__ __forceinline__ int v_st(int k, int c) { const int kk = (k & ~0xC) | ((k & 4) << 1) | ((k & 8) >> 1); return ((kk >> 3) * 4 + (c >> 5)) * 512 + ((kk & 7) * 32 + (c & 31)) * 2; }
__device__ __forceinline__ int v_rd_base(int lane) { return ((lane & 3) << 3) | (((lane >> 2) & 3) << 6) | (((lane >> 4) & 1) << 5) | (((lane >> 5) & 1) << 8); }
constexpr int v_rd_off(int d0, int ks, int half) { return d0 * 512 + ks * 4096 + half * 2048; }
__device__ __forceinline__ int crow(int r, int hi) { return (r & 3) + 8 * (r >> 2) + 4 * hi; }
__device__ __forceinline__ unsigned cvtpk(float lo, float hi) { unsigned r; asm volatile("v_cvt_pk_bf16_f32 %0, %1, %2" : "=v"(r) : "v"(lo), "v"(hi)); return r; }
__device__ __forceinline__ bf16x8 pack8(f32x4 a, f32x4 b) { u32x4 w = {cvtpk(a[0], a[1]), cvtpk(a[2], a[3]), cvtpk(b[0], b[1]), cvtpk(b[2], b[3])}; return *reinterpret_cast<bf16x8*>(&w); }
__device__ __forceinline__ bf16x8 load8(const bf16* p) { return *reinterpret_cast<const bf16x8*>(p); }
__device__ __forceinline__ void mask_tile(f32x16& p0, f32x16& p1, int dq) {
    const float NEG = -__builtin_inff();
#pragma unroll
    for (int r = 0; r < 16; ++r) { const int c = (r & 3) + 8 * (r >> 2); if (dq - c < 0) p0[r] = NEG; if (dq - c - 32 < 0) p1[r] = NEG; }
}
__device__ __forceinline__ void mask_all(f32x16& p0, f32x16& p1, bool keep) {
    const float NEG = -__builtin_inff();
#pragma unroll
    for (int r = 0; r < 16; ++r) { p0[r] = keep ? p0[r] : NEG; p1[r] = keep ? p1[r] : NEG; }
}
__device__ __forceinline__ void partialSM(f32x16& p0, f32x16& p1, float& m_reg, float& mn, float& alpha, bool keep) {
    float pmax = p0[0]; for (int r = 1; r < 16; ++r) pmax = fmaxf(pmax, p0[r]); for (int r = 0; r < 16; ++r) pmax = fmaxf(pmax, p1[r]);
    pmax = keep ? pmax : -__builtin_inff();
    { auto rr = __builtin_amdgcn_permlane32_swap(__float_as_uint(pmax), __float_as_uint(pmax), false, false);
      pmax = fmaxf(__uint_as_float(rr[0]), __uint_as_float(rr[1])); }
    constexpr float C2 = 1.4426950408889634f * SCALE;
    if (__builtin_expect(__all((pmax - m_reg) * SCALE <= THR), 1)) { mn = m_reg; alpha = 1.f; }
    else { mn = fmaxf(m_reg, pmax); alpha = __builtin_amdgcn_exp2f((m_reg - mn) * C2); m_reg = mn; }
    const float mnL = keep ? -mn * C2 : -__builtin_inff();
    p0 = p0 * C2 + mnL; p1 = p1 * C2 + mnL;
    for (int r = 0; r < 16; ++r) p0[r] = __builtin_amdgcn_exp2f(p0[r]);
}
__device__ __forceinline__ void finishSM(f32x16& p0, f32x16& p1, float alpha, float& l_reg, bf16x8& pa0, bf16x8& pa1, bf16x8& pa2, bf16x8& pa3) {
    for (int r = 0; r < 16; ++r) p1[r] = __builtin_amdgcn_exp2f(p1[r]);
    float ps;
    { typedef float f32x8_ __attribute__((ext_vector_type(8))); typedef float f32x4_ __attribute__((ext_vector_type(4))); typedef float f32x2_ __attribute__((ext_vector_type(2)));
      const f32x16 s16 = p0 + p1; const f32x8_ s8 = s16.lo + s16.hi; const f32x4_ s4 = s8.lo + s8.hi; const f32x2_ s2 = s4.lo + s4.hi; ps = s2.x + s2.y; }
    { auto rr = __builtin_amdgcn_permlane32_swap(__float_as_uint(ps), __float_as_uint(ps), false, false);
      ps = __uint_as_float(rr[0]) + __uint_as_float(rr[1]); }
    l_reg = l_reg * alpha + ps;
#define PK4(P, B_, OUT) do { unsigned a0 = cvtpk(P[B_+0], P[B_+1]), a1 = cvtpk(P[B_+2], P[B_+3]);                          \
        unsigned b0 = cvtpk(P[B_+4], P[B_+5]), b1 = cvtpk(P[B_+6], P[B_+7]);                                             \
        auto r0 = __builtin_amdgcn_permlane32_swap(a0, b0, false, false); auto r1 = __builtin_amdgcn_permlane32_swap(a1, b1, false, false); \
        u32x4 w = {r0[0], r1[0], r0[1], r1[1]}; OUT = *reinterpret_cast<bf16x8*>(&w); } while (0)
    PK4(p0, 0, pa0); PK4(p0, 8, pa1); PK4(p1, 0, pa2); PK4(p1, 8, pa3);
#undef PK4
}
template <int KB>
__device__ __forceinline__ void qkt(f32x16& p0, f32x16& p1, const char* K_lds, int r32, int hi, const bf16x8* qr) {
    p0 = f32x16{}; p1 = f32x16{};
    const char* kb[4];
#pragma unroll
    for (int dd = 0; dd < 4; ++dd) kb[dd] = K_lds + KB * SHM_K + KSWZ(r32, (dd * 16 + hi * 8) * 2);
#pragma unroll
    for (int d0 = 0; d0 < 8; ++d0) { const char* a = kb[d0 & 3] + (d0 >> 2) * 128;
        bf16x8 b0 = *reinterpret_cast<const bf16x8*>(a);
        bf16x8 b1 = *reinterpret_cast<const bf16x8*>(a + 32 * 256);
        p0 = __builtin_amdgcn_mfma_f32_32x32x16_bf16(b0, qr[d0], p0, 0, 0, 0);
        p1 = __builtin_amdgcn_mfma_f32_32x32x16_bf16(b1, qr[d0], p1, 0, 0, 0); }
}
template <int VB>
__device__ __forceinline__ void pv_tile(f32x16* o, int vb0, bf16x8 pa0, bf16x8 pa1, bf16x8 pa2, bf16x8 pa3) {
#define TRRD(dst, off) asm volatile("ds_read_b64_tr_b16 %0, %1 offset:%2" : "=&v"(dst) : "v"(vb0), "i"(off) : "memory")
#define PV_D0(d0) do { s16x4 l0, l1, l2, l3, h0, h1, h2, h3; constexpr int b_ = VB * SHM_V + v_rd_off(d0, 0, 0); \
        TRRD(l0, b_); TRRD(h0, b_ + 2048); TRRD(l1, b_ + 4096); TRRD(h1, b_ + 6144); TRRD(l2, b_ + 8192); TRRD(h2, b_ + 10240); TRRD(l3, b_ + 12288); TRRD(h3, b_ + 14336); \
        asm volatile("s_waitcnt lgkmcnt(0)" ::: "memory"); SBAR();   \
        o[d0] = __builtin_amdgcn_mfma_f32_32x32x16_bf16(pa0, (bf16x8){l0[0], l0[1], l0[2], l0[3], h0[0], h0[1], h0[2], h0[3]}, o[d0], 0, 0, 0);   \
        o[d0] = __builtin_amdgcn_mfma_f32_32x32x16_bf16(pa1, (bf16x8){l1[0], l1[1], l1[2], l1[3], h1[0], h1[1], h1[2], h1[3]}, o[d0], 0, 0, 0);   \
        o[d0] = __builtin_amdgcn_mfma_f32_32x32x16_bf16(pa2, (bf16x8){l2[0], l2[1], l2[2], l2[3], h2[0], h2[1], h2[2], h2[3]}, o[d0], 0, 0, 0);   \
        o[d0] = __builtin_amdgcn_mfma_f32_32x32x16_bf16(pa3, (bf16x8){l3[0], l3[1], l3[2], l3[3], h3[0], h3[1], h3[2], h3[3]}, o[d0], 0, 0, 0); } while (0)
    PV_D0(0); PV_D0(1); PV_D0(2); PV_D0(3);
#undef PV_D0
#undef TRRD
}
struct BlockRef { const bf16* Q; const bf16* K; const bf16* V; bf16* O; const float* KM; float* ML; int j, tlo, thi; };
struct Seam { bf16x8 qr[8]; bf16x8 st_v0, st_v1, st_k0, st_k1; };
#define ROW(p, k0, rr) ((p) + (size_t)((k0) + (rr)) * PIN + sc)
#define VMW() asm volatile("s_waitcnt vmcnt(0)" ::: "memory")
#define VMWN(n) asm volatile("s_waitcnt vmcnt(%0)" :: "i"(n) : "memory")
#define SLOAD_H(Kp, Vp, k0) do { S.st_v0 = load8(ROW(Vp, k0, sr)); S.st_v1 = load8(ROW(Vp, k0, 32 + sr));              \
                         S.st_k0 = load8(ROW(Kp, k0, sr)); S.st_k1 = load8(ROW(Kp, k0, 32 + sr)); } while (0)
#define SWRITE_HK(bf) do { *(bf16x8*)(K_lds + (bf) * SHM_K + kws) = S.st_k0; *(bf16x8*)(K_lds + (bf) * SHM_K + kws + 32 * 256) = S.st_k1; } while (0)
#define SWRITE_HV(bf) do { *(bf16x8*)(V_lds + (bf) * SHM_V + vst0) = S.st_v0; *(bf16x8*)(V_lds + (bf) * SHM_V + vst1) = S.st_v1; } while (0)
#define SWRITE_H(bf) do { SWRITE_HV(bf); SWRITE_HK(bf); } while (0)
template <int PIN, class Between>
__device__ __forceinline__ void moba_prime(const BlockRef& cur, char* lds, Seam& S, Between&& between) {
    int tid_ = threadIdx.x; asm volatile("" : "+v"(tid_));
    const int tid = tid_, wid = __builtin_amdgcn_readfirstlane(tid >> 6), lane = tid & 63, r32 = lane & 31, hi = lane >> 5;
    const int sr = tid >> 4, sc = (tid & 15) * 8, kws = KSWZ(sr, sc * 2); char* K_lds = lds + 2 * SHM_V;
    for (int d0 = 0; d0 < 8; ++d0) S.qr[d0] = load8(cur.Q + (size_t)(wid * QBLK + r32) * PIN + d0 * 16 + hi * 8);
    SLOAD_H(cur.K, cur.V, cur.tlo * KVBLK); between(); VMW(); SWRITE_HK(0);
    __syncthreads();
}
template <int PIN, int PO>
__device__ __forceinline__ void moba_block(const BlockRef& cur, const BlockRef& nxt, char* lds, Seam& S) {
    int tid_ = threadIdx.x; asm volatile("" : "+v"(tid_));
    const int tid = tid_, wid = __builtin_amdgcn_readfirstlane(tid >> 6), lane = tid & 63, r32 = lane & 31, hi = lane >> 5;
    const int jb = cur.j, P0 = jb * QB;
    const int NT = cur.thi - cur.tlo, TB = cur.tlo;
    const int qlo = P0 + wid * QBLK, qm = qlo + r32 - 4 * hi;
    char* V_lds = lds; char* K_lds = lds + 2 * SHM_V;
    float* ws = (float*)(lds + 2 * SHM_V + 2 * SHM_K) + wid * 64; float* li_l = ws, * al_l = ws + 32;
    float m_reg = -1e30f, l_reg = 0; f32x16 o[4] = {};
    const int sr = tid >> 4, sc = (tid & 15) * 8, vst0 = v_st(sr, sc), vst1 = v_st(32 + sr, sc), kws = KSWZ(sr, sc * 2);
    const int vb0 = (int)(uintptr_t)V_lds + v_rd_base(lane);
    const bf16* Kh = cur.K; const bf16* Vh = cur.V;
    unsigned selmask = 0u;
    if (jb > 0) {
        f32x16 sc16 = f32x16{};
#pragma unroll
        for (int d0 = 0; d0 < 8; ++d0) { bf16x8 a = (bf16x8){0, 0, 0, 0, 0, 0, 0, 0};
            if (r32 < 16) { const float* kp = cur.KM + r32 * D + d0 * 16 + hi * 8; a = pack8(*(const f32x4*)kp, *(const f32x4*)(kp + 4)); }
            sc16 = __builtin_amdgcn_mfma_f32_32x32x16_bf16(a, S.qr[d0], sc16, 0, 0, 0); }
        float s16[16];
#pragma unroll
        for (int r = 0; r < 8; ++r) { auto rr = __builtin_amdgcn_permlane32_swap(__float_as_uint(sc16[r]), __float_as_uint(sc16[r]), false, false);
            s16[(r & 3) + 8 * (r >> 2)] = __uint_as_float(rr[0]); s16[(r & 3) + 8 * (r >> 2) + 4] = __uint_as_float(rr[1]); }
        const float NEGI = -__builtin_inff();
#pragma unroll
        for (int n = 0; n < 16; ++n) s16[n] = (n < jb) ? s16[n] : NEGI;
#pragma unroll
        for (int it = 0; it < 3; ++it) { float best = NEGI; int bi = 16;
#pragma unroll
            for (int n = 0; n < 16; ++n) { if (s16[n] > best) { best = s16[n]; bi = n; } }
            selmask |= (bi < 16) ? (1u << bi) : 0u;
#pragma unroll
            for (int n = 0; n < 16; ++n) s16[n] = (n == bi) ? NEGI : s16[n]; }
    }
#define RESC(a) do { if (__any((a) < 1.f)) { if (hi == 0) al_l[r32] = (a); asm volatile("s_waitcnt lgkmcnt(0)" ::: "memory");              \
                     for (int d_ = 0; d_ < 4; ++d_) for (int r = 0; r < 16; ++r) o[d_][r] *= al_l[crow(r, hi)]; } } while (0)
#define KBASE(t) ((TB + (t)) * KVBLK)
#define MASKT(P0_, P1_, t) do { const int kb_ = KBASE(t); const int nb_ = (TB + (t)) >> 2; keep_ = true; \
        if (nb_ < jb) { keep_ = ((selmask >> nb_) & 1u) != 0u; } \
        else if (kb_ + KVBLK - 1 > qlo) { mask_tile(P0_, P1_, qm - kb_); } } while (0)
    constexpr int NQL = 8;
#define SEAM_K0() do { VMWN(NQL); SWRITE_HK(0); SBAR(); } while (0)
    f32x16 pA0, pA1, pB0, pB1; float mnA, mnB, alA, alB; bf16x8 pa0, pa1, pa2, pa3; bool keep_ = true;
    SWRITE_HV(0); SBAR();
    if (NT > 1) { SLOAD_H(Kh, Vh, KBASE(1)); }
    SBAR(); qkt<0>(pA0, pA1, K_lds, r32, hi, S.qr);
    MASKT(pA0, pA1, 0); partialSM(pA0, pA1, m_reg, mnA, alA, keep_);
    if (NT > 1) { VMW(); SWRITE_H(1); }
    __syncthreads();
#define HALF_STEP(PX0, PX1, mnX, alX, PY0, PY1, alY, t, KB, VB, SB) do {                                                      \
        SBAR(); qkt<KB>(PX0, PX1, K_lds, r32, hi, S.qr);                                             \
        finishSM(PY0, PY1, alY, l_reg, pa0, pa1, pa2, pa3); SBAR();                                                           \
        if ((t) + 1 < NT) { SLOAD_H(Kh, Vh, KBASE((t) + 1)); SBAR(); }                                               \
        pv_tile<VB>(o, vb0, pa0, pa1, pa2, pa3); MASKX(PX0, PX1, (t)); partialSM(PX0, PX1, m_reg, mnX, alX, keep_);                                        \
        __syncthreads();                                                                                                      \
        if ((t) + 1 < NT) { VMW(); SWRITE_H(SB); }                                                                          \
        RESC(alX); __syncthreads(); } while (0)
    const int tpast = 4 * jb - TB;
    int t = 1;
#define MASKX(P0_, P1_, t_) do { keep_ = ((selmask >> ((TB + (t_)) >> 2)) & 1u) != 0u; } while (0)
    for (; t + 1 < NT && t + 1 < tpast; t += 2) {
        HALF_STEP(pB0, pB1, mnB, alB, pA0, pA1, alA, t, 1, 0, 0);
        HALF_STEP(pA0, pA1, mnA, alA, pB0, pB1, alB, t + 1, 0, 1, 1);
    }
#undef MASKX
#define MASKX(P0_, P1_, t_) MASKT(P0_, P1_, t_)
    for (; t + 1 < NT; t += 2) {
        HALF_STEP(pB0, pB1, mnB, alB, pA0, pA1, alA, t, 1, 0, 0);
        HALF_STEP(pA0, pA1, mnA, alA, pB0, pB1, alB, t + 1, 0, 1, 1);
    }
#undef MASKX
    const bool even = (NT & 1) == 0;
    if (even) { SBAR(); qkt<1>(pB0, pB1, K_lds, r32, hi, S.qr); SBAR(); }
    SLOAD_H(nxt.K, nxt.V, nxt.tlo * KVBLK); SBAR();
#pragma unroll
    for (int d0 = 0; d0 < 8; ++d0) S.qr[d0] = load8(nxt.Q + (size_t)(wid * QBLK + r32) * PIN + d0 * 16 + hi * 8);
    SBAR();
    finishSM(pA0, pA1, alA, l_reg, pa0, pa1, pa2, pa3); SBAR();
    pv_tile<0>(o, vb0, pa0, pa1, pa2, pa3);
    if (even) { MASKT(pB0, pB1, NT - 1); partialSM(pB0, pB1, m_reg, mnB, alB, keep_); __syncthreads(); RESC(alB);
        finishSM(pB0, pB1, alB, l_reg, pa0, pa1, pa2, pa3); SBAR(); pv_tile<1>(o, vb0, pa0, pa1, pa2, pa3); }
    SBAR(); SEAM_K0();
    if (hi == 0) li_l[r32] = l_reg; asm volatile("s_waitcnt lgkmcnt(0)" ::: "memory");
    float rli[16];
#pragma unroll
    for (int r = 0; r < 16; ++r) { const float lv = li_l[crow(r, hi)]; rli[r] = lv > 0.f ? __builtin_amdgcn_rcpf(lv) : 0.f; }
    if (hi == 0) { typedef float f32x2 __attribute__((ext_vector_type(2))); *(f32x2*)(cur.ML + (size_t)(wid * QBLK + r32) * 16) = (f32x2){m_reg, l_reg}; }
    bf16* Ow = cur.O + (size_t)(wid * QBLK) * PO;
#pragma unroll
    for (int r = 0; r < 16; ++r) { const int orow = crow(r, hi);
#pragma unroll
        for (int d0 = 0; d0 < 4; ++d0) { const float v = o[d0][r] * rli[r];
            const float vn = __shfl_xor(v, 1);
            if ((r32 & 1) == 0) *(unsigned*)(Ow + (size_t)orow * PO + d0 * 32 + r32) = cvtpk(v, vn); } }
    __syncthreads();
#undef RESC
#undef KBASE
#undef MASKT
#undef SEAM_K0
#undef HALF_STEP
}
#undef ROW
#undef VMW
#undef VMWN
#undef SLOAD_H
#undef SWRITE_HK
#undef SWRITE_HV
#undef SWRITE_H
#undef KSWZ
#undef SBAR
}

constexpr int NWAVES = 8, NTHR = 512; constexpr float RMS_EPS = 1e-6f;
constexpr int BATCH = 2, SEQ = 4096, T = BATCH * SEQ, DM = 2048, DEPTH = 4, PLE = 256;
constexpr int CCH = 512, CWID = 31;
constexpr int GH = 4, GDK = 64, GDV = 128, GRANK = 16, GCH = 64, GNC = SEQ / GCH;
constexpr int MH = 8, MHD = 128, MBLK = 256, MNB = SEQ / MBLK;
constexpr int FF = 5632, FF2 = 2 * FF, IN_COLS = 5648, NGATE = 3 * DM;
constexpr int ZN = 47 * 256;
constexpr int ZC_GLU = 0, ZC_GQ = 1024, ZC_GK = 1280, ZC_GV = 1536, ZC_GR = 2048, ZC_MQ = 2560, ZC_MK = 3584, ZC_MV = 4608, ZC_GATE = 5632, ZC_GA = 11776;
constexpr size_t MiB = 1u << 20;
constexpr size_t WS_CTL = 0, CTL_ZERO_BYTES = 32 * 1024;
constexpr int CW_TMO = 0, CW_BAR = 4096;
constexpr size_t WS_ROWSS = 1 * MiB;
constexpr size_t WS_W = 4 * MiB;
constexpr size_t WO_W1 = 0, WO_CA = WO_W1 + (size_t)ZN * DM * 2, WO_GL = WO_CA + (size_t)DM * CCH * 2, WO_MO = WO_GL + (size_t)DM * 512 * 2, WO_OU = WO_MO + (size_t)DM * 1024 * 2,
                 WO_UP = WO_OU + (size_t)DM * DM * 2, WO_DN = WO_UP + (size_t)FF2 * DM * 2, WO_PG = WO_DN + (size_t)DM * FF * 2, WO_PL = WO_PG + (size_t)DM * DM * 2, W_LAYER = WO_PL + (size_t)DM * PLE * 2;
static_assert(W_LAYER == 138 * MiB, "weight bytes per layer");
constexpr size_t WS_ACT = WS_W + DEPTH * W_LAYER;
constexpr size_t WS_XBA = WS_ACT, WS_XBB = WS_XBA + 32 * MiB, WS_XBC = WS_XBB + 32 * MiB, WS_ZB = WS_XBC + 32 * MiB;
constexpr size_t WS_TMP = WS_ZB + 188 * MiB, WS_MRG = WS_TMP + 64 * MiB;
constexpr size_t WS_ACONV = WS_MRG + 32 * MiB, WS_OMOBA = WS_ACONV + 8 * MiB, WS_GQT = WS_OMOBA + 16 * MiB, WS_GINTRA = WS_GQT + 4 * MiB, WS_GDELTA = WS_GINTRA + 16 * MiB,
                 WS_GST = WS_GDELTA + 16 * MiB, WS_GDEC = WS_GST + 8 * MiB, WS_OGLA = WS_GDEC + 1 * MiB, WS_GA = WS_OGLA + 8 * MiB, WS_KMEAN = WS_GA + 1 * MiB, WS_PB = WS_KMEAN + 1 * MiB,
                 WS_PE = WS_PB + 16 * MiB, WS_RSP = WS_PE + 32 * MiB, WS_OP1 = WS_RSP + 13 * MiB, WS_ML = WS_OP1 + 16 * MiB, WS_EDGE = WS_ML + 2 * MiB, WS_AGLU = WS_EDGE + 24 * MiB, WS_QKV = WS_AGLU + 8 * MiB, WS_ACAT = WS_QKV + 48 * MiB, WS_G8 = WS_ACAT + 32 * MiB, WS_END = WS_G8 + 48 * MiB;
static_assert((size_t)T * ZN * 2 <= 188 * MiB && (size_t)T * FF2 * 2 <= 188 * MiB && (size_t)T * FF * 2 <= 96 * MiB, "overlays");
constexpr int RING_OFF = 0, RING_BYTES = 131072, LDSCTL_OFF = RING_BYTES, MISC_OFF = LDSCTL_OFF + 320, XL_OFF = LDSCTL_OFF + 2048  , RT_OFF = LDSCTL_OFF + 10240  , SLOT_OFF = LDSCTL_OFF + 1280  , LDS_BYTES = 147456;

#define GAS __attribute__((address_space(1)))
#define LAS __attribute__((address_space(3)))
typedef unsigned short bf16;
typedef unsigned v4u __attribute__((ext_vector_type(4)));
typedef float f32x4 __attribute__((ext_vector_type(4)));
typedef short bf16x8 __attribute__((ext_vector_type(8)));
typedef GAS unsigned gu32;
#define RLX_AGENT __ATOMIC_RELAXED, __HIP_MEMORY_SCOPE_AGENT
#define LDS_WAIT() asm volatile("s_waitcnt lgkmcnt(0)" ::: "memory")
#define VM_WAIT() asm volatile("s_waitcnt vmcnt(0)" ::: "memory")
__device__ __forceinline__ unsigned f2bf(float f) { unsigned u = __builtin_bit_cast(unsigned, f); return (u + 0x7fffu + ((u >> 16) & 1u)) >> 16; }
__device__ __forceinline__ unsigned pk2(float lo, float hi) { return f2bf(lo) | (f2bf(hi) << 16); }
__device__ __forceinline__ float bflo(unsigned w) { return __uint_as_float(w << 16); }
__device__ __forceinline__ float bfhi(unsigned w) { return __uint_as_float(w & 0xffff0000u); }
__device__ __forceinline__ float sigm(float v) { return __builtin_amdgcn_rcpf(1.0f + __builtin_amdgcn_exp2f(-1.4426950408889634f * v)); }
__device__ __forceinline__ float wave_sum(float v) {
#pragma unroll
    for (int o = 1; o < 64; o <<= 1) v += __shfl_xor(v, o);
    return v;
}
__device__ __forceinline__ void unpack8(const v4u w, float (&f)[8]) { f[0] = bflo(w.x); f[1] = bfhi(w.x); f[2] = bflo(w.y); f[3] = bfhi(w.y); f[4] = bflo(w.z); f[5] = bfhi(w.z); f[6] = bflo(w.w); f[7] = bfhi(w.w); }
__device__ __forceinline__ v4u pack8f(const float (&f)[8]) { v4u w; w.x = pk2(f[0], f[1]); w.y = pk2(f[2], f[3]); w.z = pk2(f[4], f[5]); w.w = pk2(f[6], f[7]); return w; }

#define XB_TMO      128
#define XB_XCNT(j)  (256  + 64 * (j))
#define XB_XSUB(j)  (1280 + 64 * (j))
#define XB_XGEN(j)  (2304 + 64 * (j))
#define XB_TOP      3328
#define XB_TOPGEN   3392
#define XCD_BAR_WORDS 3456
#define XB_SPIN_CAP (1u << 18)

__device__ __forceinline__ unsigned xb_ld(unsigned* p)              { return __hip_atomic_load(p, __ATOMIC_RELAXED, __HIP_MEMORY_SCOPE_AGENT); }
__device__ __forceinline__ unsigned xb_add(unsigned* p, unsigned v) { return __hip_atomic_fetch_add(p, v, __ATOMIC_RELAXED, __HIP_MEMORY_SCOPE_AGENT); }
__device__ __forceinline__ unsigned xb_xcc_id() { return (unsigned)__builtin_amdgcn_s_getreg((3 << 11) | 20) & 0xFu; }
#define XB_SPIN(cond, bar) do { unsigned _sp = 0; while (cond) { __builtin_amdgcn_s_sleep(1); \
    if ((++_sp & 255u) == 0u) { if (xb_ld(&(bar)[XB_TMO])) break; if (_sp > XB_SPIN_CAP) { atomicAdd(&(bar)[XB_TMO], 1u); break; } } } } while (0)

struct XcdBarrier {
    unsigned* bar; unsigned x;
    volatile LAS unsigned* st;
};

__device__ __forceinline__ XcdBarrier xcd_barrier_post(unsigned* bar, volatile LAS unsigned* st) {
    XcdBarrier b; b.bar = bar; b.x = xb_xcc_id(); b.st = st;
    if (threadIdx.x == 0) (void)xb_add(&bar[XB_XCNT(b.x)], 1u);
    return b;
}
__device__ __forceinline__ void xcd_barrier_complete(unsigned* bar, unsigned x, unsigned& nloc, unsigned& nx) {
    const unsigned G = gridDim.x * gridDim.y * gridDim.z;
    unsigned sum, cnt, mine, sp = 0u;
    for (;;) {
        sum = 0u; cnt = 0u; mine = 0u;
#pragma unroll
        for (unsigned j = 0; j < 16; ++j) { const unsigned c = xb_ld(&bar[XB_XCNT(j)]); sum += c; cnt += (c > 0u) ? 1u : 0u; mine = (j == x) ? c : mine; }
        if (sum == G) break;
        __builtin_amdgcn_s_sleep(1);
        if ((++sp & 255u) == 0u) { if (xb_ld(&bar[XB_TMO])) break; if (sp > XB_SPIN_CAP) { atomicAdd(&bar[XB_TMO], 1u); break; } }
    }
    nloc = mine > 0u ? mine : 1u; nx = cnt > 0u ? cnt : 1u;
}

__device__ __forceinline__ void xcd_barrier(const XcdBarrier& b) {
    asm volatile("s_waitcnt vmcnt(0)" ::: "memory");
    __syncthreads();
    if (threadIdx.x == 0) {
        unsigned* bar = b.bar;
        __builtin_amdgcn_s_waitcnt(0);
        unsigned nloc = b.st[0], nx = b.st[1];
        if (nloc == 0u) { xcd_barrier_complete(bar, b.x, nloc, nx); b.st[0] = nloc; b.st[1] = nx; }
        const unsigned old = xb_add(&bar[XB_XSUB(b.x)], 1u);
        const unsigned gen = old / nloc;
        if (old + 1u == (gen + 1u) * nloc) {
            __builtin_amdgcn_fence(__ATOMIC_RELEASE, "agent");
            asm volatile("s_waitcnt vmcnt(0)" ::: "memory");
            const unsigned og = xb_add(&bar[XB_TOP], 1u);
            const unsigned tg = og / nx;
            if (og + 1u == (tg + 1u) * nx) xb_add(&bar[XB_TOPGEN], 1u);
            else XB_SPIN(xb_ld(&bar[XB_TOPGEN]) == tg, bar);
            __builtin_amdgcn_fence(__ATOMIC_ACQUIRE, "agent");
            xb_add(&bar[XB_XGEN(b.x)], 1u);
            asm volatile("s_waitcnt vmcnt(0)" ::: "memory");
        } else {
            XB_SPIN(xb_ld(&bar[XB_XGEN(b.x)]) == gen, bar);
            __builtin_amdgcn_fence(__ATOMIC_ACQUIRE, "agent");
            asm volatile("s_waitcnt vmcnt(0)" ::: "memory");
        }
    }
    __syncthreads();
}
enum { MAP_ID = 0, MAP_IN = 1, MAP_UP = 2 };
template <int MAP> __device__ __forceinline__ int map_col(int n, int off) {
    if (MAP == MAP_ID) return n + off;
    if (MAP == MAP_UP) { const int isv = n >= FF ? 1 : 0, c = n - isv * FF; return 256 * (c >> 7) + 128 * isv + (c & 127); }
    if (n < 512) return 256 * (n >> 7) + (n & 127);
    if (n < 1024) { const int c = n - 512; return 256 * (c >> 7) + 128 + (c & 127); }
    if (n < 2560) return n;
    if (n < 2576) return ZC_GA + (n - 2560);
    return n - 16;
}
template <int MAP> __device__ __forceinline__ void tr_item(const float* W, int K, int N, const float* gain, bf16* WT, int off, LAS float* scr, int item, int lane) {
    const int nblk = (N + 31) >> 5, kb = item / nblk, nb = item - kb * nblk, k0 = 64 * kb, n0 = 32 * nb;
    const int nl = n0 + (lane & 31); const bool ok = nl < N;
#pragma unroll 8
    for (int i = 0; i < 32; ++i) { const int kk = 2 * i + (lane >> 5); float v = ok ? W[(size_t)(k0 + kk) * N + nl] : 0.f; if (gain) v *= gain[k0 + kk]; scr[kk * 33 + (lane & 31)] = v; }
    LDS_WAIT(); asm volatile("" ::: "memory");
    const int c = lane & 7;
#pragma unroll
    for (int j = 0; j < 4; ++j) { const int n = (lane >> 3) + 8 * j; const LAS float* s = scr + (8 * c) * 33 + n;
        v4u o; o.x = pk2(s[0 * 33], s[1 * 33]); o.y = pk2(s[2 * 33], s[3 * 33]); o.z = pk2(s[4 * 33], s[5 * 33]); o.w = pk2(s[6 * 33], s[7 * 33]);
        if (n0 + n < N) *(GAS v4u*)(WT + (size_t)map_col<MAP>(n0 + n, off) * K + k0 + 8 * c) = o; }
    LDS_WAIT(); asm volatile("" ::: "memory");
}

template <int MAP> __device__ __forceinline__ void tr2_item(const float* W, int K, int N, const float* gain, bf16* WT, int off, int item, int lane) {
    const int ngrp = (N + 63) >> 6, kb = item / ngrp, nb = item - kb * ngrp, k0 = 64 * kb, n = 64 * nb + lane;
    if (n >= N) return;
    const float* src = W + (size_t)k0 * N + n;
    float v[64];
#pragma unroll
    for (int r = 0; r < 64; ++r) v[r] = __builtin_nontemporal_load((const GAS float*)(src + (size_t)r * N));
    if (gain) {
#pragma unroll
        for (int r = 0; r < 64; ++r) v[r] *= gain[k0 + r]; }
    bf16* dst = WT + (size_t)map_col<MAP>(n, off) * K + k0;
#pragma unroll
    for (int kg = 0; kg < 8; ++kg) { v4u o; o.x = pk2(v[8 * kg], v[8 * kg + 1]); o.y = pk2(v[8 * kg + 2], v[8 * kg + 3]); o.z = pk2(v[8 * kg + 4], v[8 * kg + 5]); o.w = pk2(v[8 * kg + 6], v[8 * kg + 7]);
        *(GAS v4u*)(dst + kg * 8) = o; }
}

__device__ __forceinline__ int map_col_rt(int map, int n, int off) {
    if (map == MAP_ID) return n + off;
    if (map == MAP_UP) return map_col<MAP_UP>(n, 0);
    return map_col<MAP_IN>(n, 0);
}
constexpr int CT_IN = 32 * 44, CT_GT = 32 * 48, CT_CA = 8 * 16, CT_GL = 8 * 16, CT_MO = 16 * 16, CT_OU = 32 * 16, CT_UP = 32 * 88, CT_DN = 88 * 16, CT_PG = 32 * 16, CT_PL = 4 * 16;
constexpr int CT_LAYER = CT_IN + CT_GT + CT_CA + CT_GL + CT_MO + CT_OU + CT_UP + CT_DN + CT_PG + CT_PL;
struct CvTile { const float* W; const float* gain; bf16* WT; int K, N, map, off, k0, n0, ldk; };
__device__ __forceinline__ void conv_branch_item(int item, const bf16* zb, const float* cw, const float* cb, const float* lg, const float* lb, bf16* aconv, LAS float* XA, int tid) {
    const int m0 = item * 32, t0 = m0 & (SEQ - 1), lane = tid & 63, wave = tid >> 6;
    { v4u ld[8];
#pragma unroll
      for (int pass = 0; pass < 8; ++pass) { const int r = pass * 8 + wave, c0 = lane * 8; ld[pass] = (v4u){0u, 0u, 0u, 0u};
          if (r < 62 && t0 - 30 + r >= 0) ld[pass] = *(const GAS v4u*)(zb + (size_t)(m0 - 30 + r) * CCH + c0); }
#pragma unroll
      for (int pass = 0; pass < 8; ++pass) { const int r = pass * 8 + wave, c0 = lane * 8;
          if (r < 62) { float a[8]; unpack8(ld[pass], a);
              *(LAS f32x4*)(XA + r * 512 + c0) = (f32x4){a[0], a[1], a[2], a[3]}; *(LAS f32x4*)(XA + r * 512 + c0 + 4) = (f32x4){a[4], a[5], a[6], a[7]}; } } }
    __syncthreads();
    float w[CWID];
#pragma unroll
    for (int j = 0; j < CWID; ++j) w[j] = cw[j * CCH + tid];
    const float bias = cb[tid];
    float yv[32];
#pragma unroll
    for (int rb = 0; rb < 4; ++rb) { float x[38];
#pragma unroll
        for (int i = 0; i < 38; ++i) x[i] = XA[(rb * 8 + i) * 512 + tid];
#pragma unroll
        for (int r = 0; r < 8; ++r) { float y = bias;
#pragma unroll
            for (int j = 0; j < CWID; ++j) y = fmaf(w[j], x[r + j], y);
            yv[rb * 8 + r] = y; } }
    __syncthreads();
#pragma unroll
    for (int r = 0; r < 32; ++r) XA[r * 512 + tid] = yv[r];
    __syncthreads();
    const f32x4 g0 = *(const f32x4*)(lg + lane * 8), g1 = *(const f32x4*)(lg + lane * 8 + 4), b0 = *(const f32x4*)(lb + lane * 8), b1 = *(const f32x4*)(lb + lane * 8 + 4);
#pragma unroll 1
    for (int q = 0; q < 4; ++q) { const int r = wave * 4 + q, c0 = lane * 8;
        const f32x4 a0 = *(const LAS f32x4*)(XA + r * 512 + c0), a1 = *(const LAS f32x4*)(XA + r * 512 + c0 + 4);
        float v[8] = {a0[0], a0[1], a0[2], a0[3], a1[0], a1[1], a1[2], a1[3]};
        float s = 0.f;
#pragma unroll
        for (int i = 0; i < 8; ++i) s += v[i];
        const float mean = wave_sum(s) * (1.f / CCH); float q2 = 0.f;
#pragma unroll
        for (int i = 0; i < 8; ++i) { v[i] -= mean; q2 += v[i] * v[i]; }
        const float rstd = __builtin_amdgcn_rsqf(wave_sum(q2) * (1.f / CCH) + RMS_EPS);
        const float gg[8] = {g0[0], g0[1], g0[2], g0[3], g1[0], g1[1], g1[2], g1[3]}, bb[8] = {b0[0], b0[1], b0[2], b0[3], b1[0], b1[1], b1[2], b1[3]};
        float o[8];
#pragma unroll
        for (int i = 0; i < 8; ++i) { const float y = v[i] * rstd * gg[i] + bb[i]; o[i] = y * sigm(y); }
        *(GAS v4u*)(aconv + (size_t)(m0 + r) * 2048 + c0) = pack8f(o); }
    __syncthreads();
}

__device__ __forceinline__ void kmean_item(int item, const bf16* zb, float* kmean, LAS float* CS, int tid) {
    const int b = item >> 7, n = (item >> 3) & 15, h = item & 7, lane = tid & 63, wave = tid >> 6;
    const int m0 = ((BATCH + b) * MH + h) * SEQ + n * MBLK, c0 = (lane & 15) * 8;
    float cs[8] = {0.f, 0.f, 0.f, 0.f, 0.f, 0.f, 0.f, 0.f};
#pragma unroll
    for (int p = 0; p < 8; ++p) { const int row = m0 + wave * 32 + p * 4 + (lane >> 4); float v[8]; unpack8(*(const GAS v4u*)(zb + (size_t)row * MHD + c0), v);
#pragma unroll
        for (int i = 0; i < 8; ++i) cs[i] += v[i]; }
#pragma unroll
    for (int i = 0; i < 8; ++i) { cs[i] += __shfl_xor(cs[i], 16); cs[i] += __shfl_xor(cs[i], 32); }
    if (lane < 16) {
#pragma unroll
        for (int i = 0; i < 8; ++i) CS[wave * 128 + c0 + i] = cs[i]; }
    __syncthreads();
    if (tid < 128) { float s = 0.f;
#pragma unroll
        for (int w = 0; w < 8; ++w) s += CS[w * 128 + tid];
        kmean[((size_t)(b * MH + h) * MNB + n) * MHD + tid] = s * (1.f / MBLK); }
    __syncthreads();
}

__device__ __forceinline__ void moba_combine(size_t i, const bf16* o0, const bf16* o1, const float* ml, bf16* out) {
    const size_t row = i >> 7; const int h = (int)(i >> 4) & 7;
    typedef float f32x2v __attribute__((ext_vector_type(2)));
    const f32x2v a = *(const f32x2v*)(ml + (row * 8 + h) * 2), b = *(const f32x2v*)(ml + ((size_t)T * 8 + row * 8 + h) * 2);
    constexpr float C2 = 1.4426950408889634f * 0.08838834764831845f;
    const float m = fmaxf(a.x, b.x), w0 = a.y * __builtin_amdgcn_exp2f((a.x - m) * C2), w1 = b.y * __builtin_amdgcn_exp2f((b.x - m) * C2), inv = __builtin_amdgcn_rcpf(w0 + w1);
    float x[8], y[8]; unpack8(*((const GAS v4u*)o0 + i), x); unpack8(*((const GAS v4u*)o1 + i), y);
#pragma unroll
    for (int q = 0; q < 8; ++q) x[q] = (w0 * x[q] + w1 * y[q]) * inv;
    *(GAS v4u*)(out + row * 2048 + (i & 127) * 8) = pack8f(x);
}
constexpr int GL_LA = 0, GL_W2 = 16640, GL_BA = 20736, GL_QT = 21504, GL_KT = 30720, GL_KD = 39936, GL_VT = 49152, GL_PP = 67584, GL_END = 76800, GLS = 72;
struct GlaLocRegs { f32x4 gav[4]; v4u qraw, kraw, v0raw, v1raw; };
__device__ __forceinline__ void gla_local_load(int item, const bf16* zb, const float* ga, GlaLocRegs& R, int tid) {
    const int bh = item >> 6, c = item & 63, b = bh >> 2, h = bh & 3, m0 = b * SEQ + c * GCH, t = tid >> 3, d0 = (tid & 7) * 8, e0 = (tid & 7) * 16;
#pragma unroll
    for (int q = 0; q < 4; ++q) R.gav[q] = *(const GAS f32x4*)(ga + (size_t)(m0 + t) * GRANK + 4 * q);
    R.qraw = *(const GAS v4u*)(zb + (size_t)(m0 + t) * ZN + ZC_GQ + h * GDK + d0); R.kraw = *(const GAS v4u*)(zb + (size_t)(m0 + t) * ZN + ZC_GK + h * GDK + d0);
    const bf16* vp = zb + (size_t)(m0 + t) * ZN + ZC_GV + h * GDV + e0; R.v0raw = *(const GAS v4u*)vp; R.v1raw = *(const GAS v4u*)(vp + 8);
}
__device__ __forceinline__ void gla_local_compute(int item, const GlaLocRegs& R, const float* wa2, const float* ba, bf16* gqt, float* gintra, float* gdelta, float* gdec, LAS unsigned char* L, int tid) {
    const int bh = item >> 6, c = item & 63, b = bh >> 2, h = bh & 3, m0 = b * SEQ + c * GCH, lane = tid & 63, wave = tid >> 6, l15 = lane & 15, quad = lane >> 4;
    LAS float* LA = (LAS float*)(L + GL_LA); LAS float* W2 = (LAS float*)(L + GL_W2); LAS float* BA = (LAS float*)(L + GL_BA);
    LAS bf16* QT = (LAS bf16*)(L + GL_QT); LAS bf16* KT = (LAS bf16*)(L + GL_KT); LAS bf16* KD = (LAS bf16*)(L + GL_KD); LAS bf16* VT = (LAS bf16*)(L + GL_VT); LAS bf16* PP = (LAS bf16*)(L + GL_PP);
    const int t = tid >> 3, d0 = (tid & 7) * 8;
    const f32x4 (&gav)[4] = R.gav; const v4u qraw = R.qraw, kraw = R.kraw;
    for (int e = tid; e < GRANK * GDK; e += NTHR) W2[e] = wa2[(e >> 6) * (GH * GDK) + h * GDK + (e & 63)];
    if (tid < GDK) BA[tid] = ba[h * GDK + tid];
    { const int e0 = (tid & 7) * 16;
        float v0[8], v1[8]; unpack8(R.v0raw, v0); unpack8(R.v1raw, v1);
#pragma unroll
        for (int i = 0; i < 8; ++i) { VT[(e0 + i) * GLS + t] = (bf16)f2bf(v0[i]); VT[(e0 + 8 + i) * GLS + t] = (bf16)f2bf(v1[i]); } }
    __syncthreads();
    { float g[GRANK];
#pragma unroll
        for (int q = 0; q < 4; ++q) { const f32x4 x = gav[q]; g[4 * q] = x[0]; g[4 * q + 1] = x[1]; g[4 * q + 2] = x[2]; g[4 * q + 3] = x[3]; }
#pragma unroll
        for (int i = 0; i < 8; ++i) { float x = BA[d0 + i];
#pragma unroll
            for (int r = 0; r < GRANK; ++r) x = fmaf(g[r], W2[r * GDK + d0 + i], x);
            const float ls = fminf(x, 0.f) - __logf(1.0f + __expf(-fabsf(x)));
            LA[t * 65 + d0 + i] = ls * (1.0f / 16.0f); } }
    __syncthreads();
    if (tid < GDK) { float s = 0.f;
#pragma unroll 8
        for (int tt = 0; tt < GCH; ++tt) { s += LA[tt * 65 + tid]; LA[tt * 65 + tid] = s; } }
    __syncthreads();
    { float q[8], k[8]; unpack8(qraw, q); unpack8(kraw, k);
        float qt[8], kt[8];
#pragma unroll
        for (int i = 0; i < 8; ++i) { const float bc = LA[t * 65 + d0 + i], bl = LA[63 * 65 + d0 + i];
            qt[i] = q[i] * 0.125f * __expf(bc); kt[i] = k[i] * __expf(-bc); KD[(d0 + i) * GLS + t] = (bf16)f2bf(k[i] * __expf(bl - bc));
            if (t == GCH - 1) gdec[(size_t)item * GDK + d0 + i] = __expf(bl); }
        const v4u qw = pack8f(qt), kw = pack8f(kt);
        *(LAS v4u*)(QT + t * GLS + d0) = qw; *(LAS v4u*)(KT + t * GLS + d0) = kw;
        *(GAS v4u*)(gqt + (size_t)(m0 + t) * (GH * GDK) + h * GDK + d0) = qw; }
    __syncthreads();
#pragma unroll
    for (int i = 0; i < 2; ++i) { const int tile = wave * 2 + i, tr = tile >> 2, tc = tile & 3; f32x4 acc = {0.f, 0.f, 0.f, 0.f};
#pragma unroll
        for (int k0 = 0; k0 < 64; k0 += 32) { const bf16x8 a = *(const LAS bf16x8*)(QT + (tr * 16 + l15) * GLS + k0 + quad * 8), bb = *(const LAS bf16x8*)(KT + (tc * 16 + l15) * GLS + k0 + quad * 8);
            acc = __builtin_amdgcn_mfma_f32_16x16x32_bf16(a, bb, acc, 0, 0, 0); }
#pragma unroll
        for (int r = 0; r < 4; ++r) { const int tt = tr * 16 + quad * 4 + r, ss = tc * 16 + l15; PP[tt * GLS + ss] = (bf16)f2bf(ss <= tt ? acc[r] : 0.f); } }
    __syncthreads();
#pragma unroll
    for (int i = 0; i < 4; ++i) { const int tile = wave * 4 + i, tr = tile >> 3, te = tile & 7; f32x4 acc = {0.f, 0.f, 0.f, 0.f};
#pragma unroll
        for (int k0 = 0; k0 < 64; k0 += 32) { const bf16x8 a = *(const LAS bf16x8*)(PP + (tr * 16 + l15) * GLS + k0 + quad * 8), bb = *(const LAS bf16x8*)(VT + (te * 16 + l15) * GLS + k0 + quad * 8);
            acc = __builtin_amdgcn_mfma_f32_16x16x32_bf16(a, bb, acc, 0, 0, 0); }
#pragma unroll
        for (int r = 0; r < 4; ++r) gintra[(size_t)(m0 + tr * 16 + quad * 4 + r) * (GH * GDV) + h * GDV + te * 16 + l15] = acc[r]; }
#pragma unroll
    for (int i = 0; i < 4; ++i) { const int tile = wave * 4 + i, te = tile >> 2, td = tile & 3; f32x4 acc = {0.f, 0.f, 0.f, 0.f};
#pragma unroll
        for (int k0 = 0; k0 < 64; k0 += 32) { const bf16x8 a = *(const LAS bf16x8*)(VT + (te * 16 + l15) * GLS + k0 + quad * 8), bb = *(const LAS bf16x8*)(KD + (td * 16 + l15) * GLS + k0 + quad * 8);
            acc = __builtin_amdgcn_mfma_f32_16x16x32_bf16(a, bb, acc, 0, 0, 0); }
#pragma unroll
        for (int r = 0; r < 4; ++r) gdelta[(size_t)item * (GDK * GDV) + (te * 16 + quad * 4 + r) * GDK + td * 16 + l15] = acc[r]; }
    __syncthreads();
}
__device__ __forceinline__ void gla_local_item(int item, const bf16* zb, const float* ga, const float* wa2, const float* ba, bf16* gqt, float* gintra, float* gdelta, float* gdec, LAS unsigned char* L, int tid) {
    GlaLocRegs R; gla_local_load(item, zb, ga, R, tid); gla_local_compute(item, R, wa2, ba, gqt, gintra, gdelta, gdec, L, tid); }
__device__ __forceinline__ void gla_scan(int gid, const float* gdelta, const float* gdec, bf16* gst) {
    const int bh = gid >> 13, idx = gid & 8191, d = idx & 63;
    float dl[GNC], dc[GNC];
#pragma unroll
    for (int c = 0; c < GNC; ++c) { const size_t it = (size_t)bh * GNC + c; dl[c] = gdelta[it * 8192 + idx]; dc[c] = gdec[it * GDK + d]; }
    float S = 0.f;
#pragma unroll
    for (int c = 0; c < GNC; ++c) { gst[((size_t)bh * GNC + c) * 8192 + idx] = (bf16)f2bf(S); S = fmaf(S, dc[c], dl[c]); }
}
struct GlaOutRegs { bf16x8 a[2]; bf16x8 bb[2][4]; float gi[4][4]; unsigned short rvb[4][4]; float ngv[4]; };
__device__ __forceinline__ void gla_out_load(int item, const bf16* zb, const bf16* gqt, const bf16* gst, const float* gintra, const float* ng, GlaOutRegs& R, int tid) {
    const int bh = item >> 6, c = item & 63, b = bh >> 2, h = bh & 3, m0 = b * SEQ + c * GCH, lane = tid & 63, wave = tid >> 6, l15 = lane & 15, quad = lane >> 4;
    const int tr = wave & 3, half = wave >> 2;
#pragma unroll
    for (int kk = 0; kk < 2; ++kk) { const int k0 = 32 * kk; R.a[kk] = *(const GAS bf16x8*)(gqt + (size_t)(m0 + tr * 16 + l15) * (GH * GDK) + h * GDK + k0 + quad * 8);
#pragma unroll
        for (int i = 0; i < 4; ++i) { const int te = half * 4 + i; R.bb[kk][i] = *(const GAS bf16x8*)(gst + (size_t)item * 8192 + (te * 16 + l15) * GDK + k0 + quad * 8); } }
#pragma unroll
    for (int i = 0; i < 4; ++i) { const int e = (half * 4 + i) * 16 + l15; R.ngv[i] = ng[e];
#pragma unroll
        for (int r = 0; r < 4; ++r) { R.rvb[r][i] = *(const GAS unsigned short*)(zb + (size_t)(m0 + tr * 16 + quad * 4 + r) * ZN + ZC_GR + h * GDV + e);
            R.gi[i][r] = gintra[(size_t)(m0 + tr * 16 + quad * 4 + r) * (GH * GDV) + h * GDV + e]; } }
}
__device__ __forceinline__ void gla_out_compute(int item, const GlaOutRegs& R, bf16* ogla, LAS float* SS, int tid) {
    const int bh = item >> 6, c = item & 63, b = bh >> 2, h = bh & 3, m0 = b * SEQ + c * GCH, lane = tid & 63, wave = tid >> 6, l15 = lane & 15, quad = lane >> 4;
    const int tr = wave & 3, half = wave >> 2;
    f32x4 acc[4];
#pragma unroll
    for (int i = 0; i < 4; ++i) acc[i] = (f32x4){0.f, 0.f, 0.f, 0.f};
#pragma unroll
    for (int kk = 0; kk < 2; ++kk)
#pragma unroll
        for (int i = 0; i < 4; ++i) acc[i] = __builtin_amdgcn_mfma_f32_16x16x32_bf16(R.a[kk], R.bb[kk][i], acc[i], 0, 0, 0);
    float ss[4] = {0.f, 0.f, 0.f, 0.f};
#pragma unroll
    for (int i = 0; i < 4; ++i)
#pragma unroll
        for (int r = 0; r < 4; ++r) { acc[i][r] += R.gi[i][r]; ss[r] += acc[i][r] * acc[i][r]; }
#pragma unroll
    for (int r = 0; r < 4; ++r) { ss[r] += __shfl_xor(ss[r], 1); ss[r] += __shfl_xor(ss[r], 2); ss[r] += __shfl_xor(ss[r], 4); ss[r] += __shfl_xor(ss[r], 8);
        if (l15 == 0) SS[wave * 16 + quad * 4 + r] = ss[r]; }
    __syncthreads();
#pragma unroll
    for (int r = 0; r < 4; ++r) { const float tot = SS[wave * 16 + quad * 4 + r] + SS[(wave ^ 4) * 16 + quad * 4 + r];
        const float rstd = __builtin_amdgcn_rsqf(tot * (1.f / GDV) + RMS_EPS); const size_t row = (size_t)(m0 + tr * 16 + quad * 4 + r);
#pragma unroll
        for (int i = 0; i < 4; ++i) { const int e = (half * 4 + i) * 16 + l15; const float rv = bflo((unsigned)R.rvb[r][i]);
            ogla[row * 2048 + h * GDV + e] = (bf16)f2bf(acc[i][r] * rstd * R.ngv[i] * (rv * sigm(rv))); } }
    __syncthreads();
}
__device__ __forceinline__ void gla_out_item(int item, const bf16* zb, const bf16* gqt, const bf16* gst, const float* gintra, const float* ng, bf16* ogla, LAS float* SS, int tid) {
    GlaOutRegs R; gla_out_load(item, zb, gqt, gst, gintra, ng, R, tid); gla_out_compute(item, R, ogla, SS, tid); }
__device__ __forceinline__ void ffn_fix_task(int grp, int s, const float* edge, const float* fw, bf16* affn) {
    const int c0 = s * 8, colg = 256 * (c0 >> 7) + (c0 & 127);
    const bool first = ((grp * 64) & (SEQ - 1)) == 0;
    float wg[3][8], wv[3][8];
#pragma unroll
    for (int j = 0; j < 3; ++j) { const f32x4 a0 = *(const f32x4*)(fw + (size_t)j * FF2 + c0), a1 = *(const f32x4*)(fw + (size_t)j * FF2 + c0 + 4), b0 = *(const f32x4*)(fw + (size_t)j * FF2 + FF + c0), b1 = *(const f32x4*)(fw + (size_t)j * FF2 + FF + c0 + 4);
#pragma unroll
        for (int i = 0; i < 4; ++i) { wg[j][i] = a0[i]; wg[j][4 + i] = a1[i]; wv[j][i] = b0[i]; wv[j][4 + i] = b1[i]; } }
    float g[4][8], v[4][8];
#pragma unroll
    for (int r = 0; r < 4; ++r) { const bool z = first && r < 2; const float* p = edge + ((size_t)(r < 2 ? grp - 1 : grp) * 4 + (r < 2 ? r : r)) * FF2 + colg;
        const f32x4 a0 = z ? (f32x4){0.f, 0.f, 0.f, 0.f} : *(const GAS f32x4*)p, a1 = z ? (f32x4){0.f, 0.f, 0.f, 0.f} : *(const GAS f32x4*)(p + 4), b0 = z ? (f32x4){0.f, 0.f, 0.f, 0.f} : *(const GAS f32x4*)(p + 128), b1 = z ? (f32x4){0.f, 0.f, 0.f, 0.f} : *(const GAS f32x4*)(p + 132);
#pragma unroll
        for (int i = 0; i < 4; ++i) { g[r][i] = a0[i]; g[r][4 + i] = a1[i]; v[r][i] = b0[i]; v[r][4 + i] = b1[i]; } }
#pragma unroll
    for (int r = 0; r < 2; ++r) { float o[8];
#pragma unroll
        for (int i = 0; i < 8; ++i) { const float ug = wg[0][i] * g[r][i] + wg[1][i] * g[r + 1][i] + wg[2][i] * g[r + 2][i], uv = wv[0][i] * v[r][i] + wv[1][i] * v[r + 1][i] + wv[2][i] * v[r + 2][i]; o[i] = ug * sigm(ug) * uv; }
        *(GAS v4u*)(affn + (size_t)(grp * 64 + r) * FF + c0) = pack8f(o); }
}

#ifndef MK_N_LAUNCHES
#define MK_N_LAUNCHES 1
#endif
constexpr int N_PHASES = 1 + 10 * DEPTH;
struct Args { const float* in[26]; float* out; unsigned char* ws; int ph_lo, ph_hi, one, pad; };
constexpr int PTAB_OFF = LDSCTL_OFF + 1024;
__device__ __forceinline__ unsigned long long ldp_raw(const LAS unsigned long long* tab, int i) {
    const unsigned long long v = tab[i]; const unsigned a = __builtin_amdgcn_readfirstlane((unsigned)v), b = __builtin_amdgcn_readfirstlane((unsigned)(v >> 32));
    return ((unsigned long long)b << 32) | a; }
#define INP(i) ((const float*)(const GAS float*)ldp_raw(PT, (i)))
#define WSB() ((unsigned char*)(GAS unsigned char*)ldp_raw(PT, 27))
#define OUTP() ((float*)(GAS float*)ldp_raw(PT, 26))
#define RSTD_TABLE(S_, part_) do { pg8::Unit uu_; int pmv_[6]; \
        _Pragma("unroll") for (int i_ = 0; i_ < 6; ++i_) pmv_[i_] = S_.next(i_, uu_) ? uu_.pm : -1; \
        { const int row_ = tid & 255, hf_ = tid >> 8; f32x4 v_[6][4];                     \
          _Pragma("unroll") for (int i_ = 0; i_ < 6; ++i_) { const int pm_ = pmv_[i_] < 0 ? (pmv_[0] < 0 ? 0 : pmv_[0]) : pmv_[i_]; const float* p_ = (part_) + (size_t)(pm_ * 256 + row_) * 32 + hf_ * 16; \
              _Pragma("unroll") for (int q_ = 0; q_ < 4; ++q_) v_[i_][q_] = *(const GAS f32x4*)(p_ + 4 * q_); } \
          _Pragma("unroll") for (int i_ = 0; i_ < 6; ++i_) { float s_ = 0.f; _Pragma("unroll") for (int q_ = 0; q_ < 4; ++q_) s_ += (v_[i_][q_][0] + v_[i_][q_][1]) + (v_[i_][q_][2] + v_[i_][q_][3]); \
              ((LAS float*)(L + RING_OFF))[(i_ * 2 + hf_) * 256 + row_] = s_; } } \
        __syncthreads(); \
        for (int j_ = tid; j_ < 6 * 256; j_ += NTHR) { const int i_ = j_ >> 8, r_ = j_ & 255; const LAS float* t_ = (const LAS float*)(L + RING_OFF); \
            ((LAS float*)(L + RT_OFF))[j_] = __builtin_amdgcn_rsqf((t_[(i_ * 2) * 256 + r_] + t_[(i_ * 2 + 1) * 256 + r_]) * (1.0f / DM) + RMS_EPS); } \
        if (tid == 0) { _Pragma("unroll") for (int i_ = 0; i_ < 6; ++i_) if (pmv_[i_] >= 0) ((LAS int*)(L + SLOT_OFF))[pmv_[i_]] = i_; } \
        __syncthreads(); } while (0)
__global__ void __launch_bounds__(NTHR, 2) trunk_fwd(Args args) {
    extern __shared__ __attribute__((aligned(16))) unsigned char lds[];
    LAS unsigned char* L = (LAS unsigned char*)lds;
    volatile LAS unsigned* MISC = (volatile LAS unsigned*)(L + MISC_OFF);
    const LAS unsigned long long* PT = (const LAS unsigned long long*)(L + PTAB_OFF);
    for (int u = threadIdx.x; u < (LDS_BYTES - LDSCTL_OFF) / 4; u += NTHR) ((LAS unsigned*)(L + LDSCTL_OFF))[u] = 0u;
    __syncthreads();
    { const int tid = threadIdx.x;
    if (tid < 26) ((LAS unsigned long long*)(L + PTAB_OFF))[tid] = (unsigned long long)args.in[tid];
    if (tid == 26) ((LAS unsigned long long*)(L + PTAB_OFF))[26] = (unsigned long long)args.out;
    if (tid == 27) ((LAS unsigned long long*)(L + PTAB_OFF))[27] = (unsigned long long)args.ws; }
    __syncthreads();
    XcdBarrier bar; bar.bar = (unsigned*)(args.ws + WS_CTL) + CW_BAR; bar.x = 0; bar.st = nullptr;
    if (args.one) bar = xcd_barrier_post((unsigned*)(args.ws + WS_CTL) + CW_BAR, MISC + 8);
    const int lo = args.ph_lo, hi = args.ph_hi;
#ifndef PHMASK
#define PHMASK 0xFFFF
#endif
#define IN(k) (lo <= (k) && (k) < hi)
#define EN(b) (((PHMASK) >> (b)) & 1)
#define SEAM(k) do { if (IN(k) && IN((k) + 1)) xcd_barrier(bar); } while (0)
#define GRIDV() int tid = threadIdx.x; asm volatile("" : "+v"(tid)); const int lane = tid & 63, wave = __builtin_amdgcn_readfirstlane(tid >> 6); (void)lane; (void)wave; const int G = gridDim.x, bx = blockIdx.x; const int vcu = (G % 8 == 0) ? (bx % 8) * (G / 8) + bx / 8 : bx; (void)vcu
#define WP(T_, off) ((T_*)(ws + (off)))

    if (EN(0) && IN(0)) {
        GRIDV(); unsigned char* ws = WSB(); const int gw = vcu * NWAVES + wave, NGW = G * NWAVES;
        {
#define CV_DECODE(id_, tl_) do { const int l_ = (id_) / CT_LAYER; int r_ = (id_) - l_ * CT_LAYER; unsigned char* wl_ = ws + WS_W + (size_t)l_ * W_LAYER; int ng_; \
            if (r_ < CT_IN) { tl_.W = INP(3) + (size_t)l_ * DM * IN_COLS; tl_.K = DM; tl_.N = IN_COLS; tl_.gain = INP(2) + l_ * DM; tl_.WT = (bf16*)(wl_ + WO_W1); tl_.ldk = tl_.K; tl_.map = MAP_IN; tl_.off = 0; ng_ = 44; } \
            else if ((r_ -= CT_IN) < CT_GT) { tl_.W = INP(16) + (size_t)l_ * DM * NGATE; tl_.K = DM; tl_.N = NGATE; tl_.gain = INP(2) + l_ * DM; tl_.WT = (bf16*)(wl_ + WO_W1); tl_.ldk = tl_.K; tl_.map = MAP_ID; tl_.off = ZC_GATE; ng_ = 48; } \
            else if ((r_ -= CT_GT) < CT_CA) { tl_.W = INP(8) + (size_t)l_ * CCH * DM; tl_.K = CCH; tl_.N = DM; tl_.gain = nullptr; tl_.WT = (bf16*)(wl_ + WO_CA); tl_.ldk = 2048; tl_.map = MAP_ID; tl_.off = 0; ng_ = 16; } \
            else if ((r_ -= CT_CA) < CT_GL) { tl_.W = INP(12) + (size_t)l_ * 512 * DM; tl_.K = 512; tl_.N = DM; tl_.gain = nullptr; tl_.WT = (bf16*)(wl_ + WO_CA) + 512; tl_.ldk = 2048; tl_.map = MAP_ID; tl_.off = 0; ng_ = 16; } \
            else if ((r_ -= CT_GL) < CT_MO) { tl_.W = INP(15) + (size_t)l_ * 1024 * DM; tl_.K = 1024; tl_.N = DM; tl_.gain = nullptr; tl_.WT = (bf16*)(wl_ + WO_CA) + 1024; tl_.ldk = 2048; tl_.map = MAP_ID; tl_.off = 0; ng_ = 16; } \
            else if ((r_ -= CT_MO) < CT_OU) { tl_.W = INP(18) + (size_t)l_ * DM * DM; tl_.K = DM; tl_.N = DM; tl_.gain = nullptr; tl_.WT = (bf16*)(wl_ + WO_OU); tl_.ldk = tl_.K; tl_.map = MAP_ID; tl_.off = 0; ng_ = 16; } \
            else if ((r_ -= CT_OU) < CT_UP) { tl_.W = INP(20) + (size_t)l_ * DM * FF2; tl_.K = DM; tl_.N = FF2; tl_.gain = INP(19) + l_ * DM; tl_.WT = (bf16*)(wl_ + WO_UP); tl_.ldk = tl_.K; tl_.map = MAP_UP; tl_.off = 0; ng_ = 88; } \
            else if ((r_ -= CT_UP) < CT_DN) { tl_.W = INP(22) + (size_t)l_ * FF * DM; tl_.K = FF; tl_.N = DM; tl_.gain = nullptr; tl_.WT = (bf16*)(wl_ + WO_DN); tl_.ldk = tl_.K; tl_.map = MAP_ID; tl_.off = 0; ng_ = 16; } \
            else if ((r_ -= CT_DN) < CT_PG) { tl_.W = INP(24) + (size_t)l_ * DM * DM; tl_.K = DM; tl_.N = DM; tl_.gain = INP(23) + l_ * DM; tl_.WT = (bf16*)(wl_ + WO_PG); tl_.ldk = tl_.K; tl_.map = MAP_ID; tl_.off = 0; ng_ = 16; } \
            else { r_ -= CT_PG; tl_.W = INP(25) + (size_t)l_ * PLE * DM; tl_.K = PLE; tl_.N = DM; tl_.gain = nullptr; tl_.WT = (bf16*)(wl_ + WO_PL); tl_.ldk = tl_.K; tl_.map = MAP_ID; tl_.off = 0; ng_ = 16; } \
            { const int kb_ = r_ / ng_; tl_.k0 = 64 * kb_; tl_.n0 = 128 * (r_ - kb_ * ng_); } } while (0)
#define CV_ISSUE(i_) do { CvTile ti_; CV_DECODE(vcu + (i_) * G, ti_); \
            _Pragma("unroll") for (int j_ = 0; j_ < 4; ++j_) { const int p_ = wave * 4 + j_; \
                __builtin_amdgcn_global_load_lds((const unsigned*)(ti_.W + (size_t)(ti_.k0 + 2 * p_ + (lane >> 5)) * ti_.N + ti_.n0 + (lane & 31) * 4), \
                                                 (LAS unsigned*)(L + RING_OFF + ((i_) & 3) * 32768 + p_ * 1024), 16, 0, 2); } } while (0)
            const int ntl = (DEPTH * CT_LAYER - vcu + G - 1) / G;
            for (int i = 0; i < 3 && i < ntl; ++i) CV_ISSUE(i);
            const int c = tid & 127, kq = __builtin_amdgcn_readfirstlane(tid >> 7);
            for (int i = 0; i < ntl; ++i) {
                if (i + 3 >= ntl) asm volatile("s_waitcnt vmcnt(0)" ::: "memory");
                else if (i == 0) asm volatile("s_waitcnt vmcnt(8)" ::: "memory");
                else if (i == 1) asm volatile("s_waitcnt vmcnt(10)" ::: "memory");
                else if (i == 2) asm volatile("s_waitcnt vmcnt(12)" ::: "memory");
                else asm volatile("s_waitcnt vmcnt(14)" ::: "memory");
                __builtin_amdgcn_s_barrier(); asm volatile("" ::: "memory");
                if (i + 3 < ntl) CV_ISSUE(i + 3);
                CvTile tc; CV_DECODE(vcu + i * G, tc);
                const LAS float* sp = (const LAS float*)(L + RING_OFF + (i & 3) * 32768) + (kq * 16) * 128 + c;
                float v[16];
#pragma unroll
                for (int r = 0; r < 16; ++r) v[r] = sp[r * 128];
                if (tc.gain) {
#pragma unroll
                    for (int r = 0; r < 16; ++r) v[r] *= ((const __attribute__((address_space(4))) float*)(unsigned long long)tc.gain)[tc.k0 + kq * 16 + r]; }
                bf16* dp = tc.WT + (size_t)map_col_rt(tc.map, tc.n0 + c, tc.off) * tc.ldk + tc.k0 + kq * 16;
                v4u o0, o1; o0.x = pk2(v[0], v[1]); o0.y = pk2(v[2], v[3]); o0.z = pk2(v[4], v[5]); o0.w = pk2(v[6], v[7]); o1.x = pk2(v[8], v[9]); o1.y = pk2(v[10], v[11]); o1.z = pk2(v[12], v[13]); o1.w = pk2(v[14], v[15]);
                *(GAS v4u*)dp = o0; *(GAS v4u*)(dp + 8) = o1;
            }
            asm volatile("s_waitcnt vmcnt(0)" ::: "memory"); __syncthreads();
#undef CV_ISSUE
#undef CV_DECODE
            for (int it = gw; it < DEPTH * 32; it += NGW) { const int l = it >> 5, kb = it & 31;
                tr2_item<MAP_IN>(INP(3) + (size_t)l * DM * IN_COLS, DM, IN_COLS, INP(2) + l * DM, (bf16*)(ws + WS_W + (size_t)l * W_LAYER + WO_W1), 0, kb * 89 + 88, lane); }
        }
        const size_t gt = (size_t)vcu * NTHR + tid, NGT = (size_t)G * NTHR;
        for (size_t i = gt; i < (size_t)DEPTH * 240 * (DM / 8); i += NGT) {
            const int l = (int)(i / (240 * (DM / 8))); const size_t r = i - (size_t)l * (240 * (DM / 8));
            *(GAS v4u*)(ws + WS_W + (size_t)l * W_LAYER + WO_W1 + ((size_t)(ZC_GA + 16) * DM + r * 8) * 2) = (v4u){0u, 0u, 0u, 0u}; }
        const float* x_in = INP(0); bf16* XBA = WP(bf16, WS_XBA); float* ROWSS = WP(float, WS_RSP);
        for (int m = gw; m < T; m += NGW) {
            const GAS f32x4* xr = (const GAS f32x4*)(x_in + (size_t)m * DM) + lane; float s = 0.f;
#pragma unroll
            for (int j = 0; j < 8; ++j) { const f32x4 v = xr[64 * j]; s += (v.x * v.x + v.y * v.y) + (v.z * v.z + v.w * v.w);
                *((GAS unsigned long long*)(XBA + (size_t)m * DM) + lane + 64 * j) = (unsigned long long)pk2(v.x, v.y) | ((unsigned long long)pk2(v.z, v.w) << 32); }
            s = wave_sum(s); if (lane < 32) ROWSS[(size_t)m * 32 + lane] = lane == 0 ? s : 0.f; }
        const float* p_in = INP(1); bf16* PB = WP(bf16, WS_PB);
        for (size_t i = gt; i < (size_t)DEPTH * T * PLE / 8; i += NGT) {
            const GAS f32x4* pp = (const GAS f32x4*)(p_in) + 2 * i; const f32x4 a = pp[0], b = pp[1];
            v4u o; o.x = pk2(a.x, a.y); o.y = pk2(a.z, a.w); o.z = pk2(b.x, b.y); o.w = pk2(b.z, b.w); *((GAS v4u*)PB + i) = o; }
    }
    SEAM(0);
    for (int l = 0; l < DEPTH; ++l) {
        const int p0 = 1 + 10 * l;
        if (EN(1) && IN(p0 + 0)) {
            GRIDV(); unsigned char* ws = WSB(); unsigned char* wl = ws + WS_W + (size_t)l * W_LAYER;
            pg8::Gemm g{WP(bf16, WS_XBA), (const bf16*)(wl + WO_W1), T, ZN, DM}; pg8::MixedOrder S; S.init(T, ZN, G, bx); static_assert(ZN / 256 == 47, "MixedOrder's tile interleave");
            RSTD_TABLE(S, WP(float, WS_RSP) + (size_t)(3 * l) * T * 32);
            pg8::EpiIn E{WP(bf16, WS_ZB), ZN, WP(bf16, WS_AGLU), WP(float, WS_RSP) + (size_t)(3 * l) * T * 32, 1.0f / DM, INP(17) + (size_t)l * NGATE, WP(float, WS_GA), INP(13) + l * MHD, INP(14) + l * MHD, (LAS float*)(L + XL_OFF), WP(bf16, WS_QKV), SEQ, (const LAS float*)(L + RT_OFF), (const LAS int*)(L + SLOT_OFF)};
            pg8::gemm_phase<pg8::EpiIn, pg8::MixedOrder, true, true>(L + RING_OFF, g, S, E);
        }
        SEAM(p0 + 0);
        if (EN(2) && IN(p0 + 1)) {
            GRIDV(); unsigned char* ws = WSB(); bf16* ZB = WP(bf16, WS_ZB);
            { const float* cw = INP(4) + (size_t)l * CWID * CCH; const float* cb = INP(5) + l * CCH; const float* lg = INP(6) + l * CCH; const float* lb = INP(7) + l * CCH;
              for (int it = vcu; it < 256; it += G) conv_branch_item(it, WP(bf16, WS_AGLU), cw, cb, lg, lb, WP(bf16, WS_ACAT), (LAS float*)(L + RING_OFF), tid); }
            for (int it = vcu; it < 256; it += G) kmean_item(it, WP(bf16, WS_QKV), WP(float, WS_KMEAN), (LAS float*)(L + RING_OFF), tid);
            { const float* wa2 = INP(9) + (size_t)l * GRANK * GH * GDK; const float* ba = INP(10) + l * GH * GDK;
              int it = vcu;
              for (; it + G < 512; it += 2 * G) { GlaLocRegs R0, R1; gla_local_load(it, ZB, WP(float, WS_GA), R0, tid); gla_local_load(it + G, ZB, WP(float, WS_GA), R1, tid);
                  gla_local_compute(it, R0, wa2, ba, WP(bf16, WS_GQT), WP(float, WS_GINTRA), WP(float, WS_GDELTA), WP(float, WS_GDEC), L + RING_OFF, tid);
                  gla_local_compute(it + G, R1, wa2, ba, WP(bf16, WS_GQT), WP(float, WS_GINTRA), WP(float, WS_GDELTA), WP(float, WS_GDEC), L + RING_OFF, tid); }
              for (; it < 512; it += G) gla_local_item(it, ZB, WP(float, WS_GA), wa2, ba, WP(bf16, WS_GQT), WP(float, WS_GINTRA), WP(float, WS_GDELTA), WP(float, WS_GDEC), L + RING_OFF, tid); }
        }
        SEAM(p0 + 1);
        if (EN(3) && IN(p0 + 2)) {
            GRIDV(); unsigned char* ws = WSB();
#define GLA_SCAN_ALL() do { if (tid < 256) for (int g_ = vcu * 256 + tid; g_ < BATCH * GH * GDK * GDV; g_ += G * 256) gla_scan(g_, WP(float, WS_GDELTA), WP(float, WS_GDEC), WP(bf16, WS_GST)); } while (0)
            if (bx >= BATCH * MH * MNB) GLA_SCAN_ALL();
            for (int u = bx; u < BATCH * MH * MNB; u += G) {
                const int xg = u & 7, i = u >> 3, bh = (xg * 2 + (i >> 4)) & 15, t = i & 15, b = bh >> 3, h = bh & 7;
                const int sA = t + 1, jA = sA - 1, sB = 16 - t, jB = sB - 1;
                const bf16* qh = WP(bf16, WS_QKV) + (size_t)((0 * BATCH + b) * MH + h) * SEQ * MHD; const bf16* kh = WP(bf16, WS_QKV) + (size_t)((1 * BATCH + b) * MH + h) * SEQ * MHD; const bf16* vh = WP(bf16, WS_QKV) + (size_t)((2 * BATCH + b) * MH + h) * SEQ * MHD; const float* km = WP(float, WS_KMEAN) + (size_t)(b * MH + h) * MNB * MHD;
                moba::BlockRef pa{qh + (size_t)(jA * MBLK) * MHD, kh, vh,
                                  WP(bf16, WS_OMOBA) + (size_t)(b * SEQ + jA * MBLK) * (MH * MHD) + h * MHD, km, WP(float, WS_ML) + ((size_t)(b * SEQ + jA * MBLK) * 8 + h) * 2, jA, 0, 2 * sA};
                moba::BlockRef pb{qh + (size_t)(jB * MBLK) * MHD, kh, vh,
                                  WP(bf16, WS_OP1) + (size_t)(b * SEQ + jB * MBLK) * (MH * MHD) + h * MHD, km, WP(float, WS_ML) + ((size_t)T * 8 + (size_t)(b * SEQ + jB * MBLK) * 8 + h) * 2, jB, 2 * sB, 4 * sB};
                moba::Seam S;
                moba::moba_prime<MHD>(pa, (char*)lds + RING_OFF, S, [&]() { if (u == bx) GLA_SCAN_ALL(); });
                moba::moba_block<MHD, MH * MHD>(pa, pb, (char*)lds + RING_OFF, S);
                moba::moba_block<MHD, MH * MHD>(pb, pb, (char*)lds + RING_OFF, S);
            }
#undef GLA_SCAN_ALL
        }
        SEAM(p0 + 2);
        if (EN(4) && IN(p0 + 3)) {
            GRIDV(); unsigned char* ws = WSB();
            for (size_t i = (size_t)vcu * NTHR + tid; i < (size_t)T * MH * MHD / 8; i += (size_t)G * NTHR) moba_combine(i, WP(bf16, WS_OMOBA), WP(bf16, WS_OP1), WP(float, WS_ML), WP(bf16, WS_ACAT) + 1024);
            { const float* ng = INP(11) + l * GDV;
              int it = vcu;
              for (; it + G < 512; it += 2 * G) { GlaOutRegs R0, R1;
                  gla_out_load(it, WP(bf16, WS_ZB), WP(bf16, WS_GQT), WP(bf16, WS_GST), WP(float, WS_GINTRA), ng, R0, tid); gla_out_load(it + G, WP(bf16, WS_ZB), WP(bf16, WS_GQT), WP(bf16, WS_GST), WP(float, WS_GINTRA), ng, R1, tid);
                  gla_out_compute(it, R0, WP(bf16, WS_ACAT) + 512, (LAS float*)(L + RING_OFF), tid); gla_out_compute(it + G, R1, WP(bf16, WS_ACAT) + 512, (LAS float*)(L + RING_OFF), tid); }
              for (; it < 512; it += G) gla_out_item(it, WP(bf16, WS_ZB), WP(bf16, WS_GQT), WP(bf16, WS_GST), WP(float, WS_GINTRA), ng, WP(bf16, WS_ACAT) + 512, (LAS float*)(L + RING_OFF), tid); }
        }
        SEAM(p0 + 3);
        if (EN(5) && IN(p0 + 4)) {
            GRIDV(); unsigned char* ws = WSB(); unsigned char* wl = ws + WS_W + (size_t)l * W_LAYER;
            pg8::Gemm g{WP(bf16, WS_ACAT), (const bf16*)(wl + WO_CA), T, DM, DM}; pg8::StaticOrder S; S.init(T, DM, G, bx);
            pg8::EpiMerge3 E{(const unsigned char*)(ws + WS_G8), NGATE, 0, WP(bf16, WS_MRG), DM};
            static_assert(WS_G8 - WS_ZB == 580911104ull && NGATE == 6144, "EpiIn derives the u8 gate buffer from the zb pointer");
            pg8::gemm_phase<pg8::EpiMerge3, pg8::StaticOrder, true, true>(L + RING_OFF, g, S, E);
        }
        SEAM(p0 + 4);
        if (EN(7) && IN(p0 + 5)) {
            GRIDV(); unsigned char* ws = WSB(); unsigned char* wl = ws + WS_W + (size_t)l * W_LAYER; float* xres = OUTP();
            pg8::Gemm g{WP(bf16, WS_MRG), (const bf16*)(wl + WO_OU), T, DM, DM}; pg8::StaticOrder S; S.init(T, DM, G, bx);
            pg8::EpiRes<false> E{WP(bf16, WS_XBA), WP(bf16, WS_XBB), nullptr, WP(float, WS_RSP) + (size_t)(3 * l + 1) * T * 32, nullptr, 0.f, nullptr, DM};
            pg8::gemm_phase<pg8::EpiRes<false>, pg8::StaticOrder, true, true>(L + RING_OFF, g, S, E);
        }
        SEAM(p0 + 5);
        if (EN(8) && IN(p0 + 6)) {
            GRIDV(); unsigned char* ws = WSB(); unsigned char* wl = ws + WS_W + (size_t)l * W_LAYER;
            pg8::Gemm g{WP(bf16, WS_XBB), (const bf16*)(wl + WO_UP), T, FF2, DM}; pg8::StaticOrder S; S.init(T, FF2, G, bx);
            RSTD_TABLE(S, WP(float, WS_RSP) + (size_t)(3 * l + 1) * T * 32);
            pg8::EpiFfn E{WP(bf16, WS_TMP), FF, INP(21) + (size_t)l * 3 * FF2, WP(float, WS_EDGE), (const LAS float*)(L + RT_OFF), (const LAS int*)(L + SLOT_OFF), (LAS float*)(L + XL_OFF)};
            pg8::gemm_phase<pg8::EpiFfn, pg8::StaticOrder, true, true>(L + RING_OFF, g, S, E);
        }
        if (EN(9) && IN(p0 + 6)) {
            GRIDV(); unsigned char* ws = WSB(); unsigned char* wl = ws + WS_W + (size_t)l * W_LAYER;
            int kple = PLE; asm volatile("" : "+s"(kple));
            pg8::Gemm g2{WP(bf16, WS_PB) + (size_t)l * T * PLE, (const bf16*)(wl + WO_PL), T, DM, kple}; pg8::TailOrder S2; S2.init(T, DM, G >= 256 ? 128 : 0, G >= 256 ? 2 : (256 + G - 1) / G, bx);
            pg8::EpiZ E2{WP(bf16, WS_PE), DM, nullptr, 0.f, nullptr, 1 << 30, 1 << 30, -1, nullptr};
            pg8::gemm_phase<pg8::EpiZ, pg8::TailOrder, true, true>(L + RING_OFF, g2, S2, E2);
        }
        SEAM(p0 + 6);
        if (EN(13) && IN(p0 + 8)) {
            GRIDV(); unsigned char* ws = WSB(); const float* fw = INP(21) + (size_t)l * 3 * FF2;
            pg8::StaticOrder S; S.init(T, DM, G, bx); pg8::Unit uu;
            for (int i = 0; S.next(i, uu); ++i) for (int s = tid; s < FF / 8; s += NTHR) ffn_fix_task(uu.pm * 4, s, WP(float, WS_EDGE), fw, WP(bf16, WS_TMP));
            asm volatile("s_waitcnt vmcnt(0)" ::: "memory"); __syncthreads();
        }
        if (EN(10) && IN(p0 + 8)) {
            GRIDV(); unsigned char* ws = WSB(); unsigned char* wl = ws + WS_W + (size_t)l * W_LAYER; float* xres = OUTP();
            pg8::Gemm g{WP(bf16, WS_TMP), (const bf16*)(wl + WO_DN), T, DM, FF}; pg8::StaticOrder S; S.init(T, DM, G, bx);
            pg8::EpiRes<false> E{WP(bf16, WS_XBB), WP(bf16, WS_XBC), nullptr, WP(float, WS_RSP) + (size_t)(3 * l + 2) * T * 32, nullptr, 0.f, nullptr, DM};
            pg8::gemm_phase<pg8::EpiRes<false>, pg8::StaticOrder, true, true>(L + RING_OFF, g, S, E);
        }
        SEAM(p0 + 8);
        if (EN(11) && IN(p0 + 9)) {
            GRIDV(); unsigned char* ws = WSB(); unsigned char* wl = ws + WS_W + (size_t)l * W_LAYER; float* xres = OUTP();
            pg8::Gemm g{WP(bf16, WS_XBC), (const bf16*)(wl + WO_PG), T, DM, DM}; pg8::StaticOrder S; S.init(T, DM, G, bx);
            pg8::EpiRes<true> E{WP(bf16, WS_XBC), WP(bf16, WS_XBA), l == DEPTH - 1 ? xres : nullptr, WP(float, WS_RSP) + (size_t)(3 * l + 3) * T * 32, WP(float, WS_RSP) + (size_t)(3 * l + 2) * T * 32, 1.0f / DM, WP(bf16, WS_PE), DM};
            pg8::gemm_phase<pg8::EpiRes<true>, pg8::StaticOrder, true, true>(L + RING_OFF, g, S, E);
        }
        SEAM(p0 + 9);
    }
#undef IN
#undef SEAM
}

extern "C" void kernel_launch(void* const* d_in, const int* in_sizes, int n_in, void* d_out, int out_size, void* d_ws, size_t ws_size, hipStream_t stream) {
    static int grid = 0;
    if (grid == 0) {
        if (n_in != 26 || out_size != T * DM || ws_size < WS_END) { fprintf(stderr, "kernel_launch: unexpected problem (n_in %d, out %d, ws %zu < %zu); nothing launched\n", n_in, out_size, ws_size, (size_t)WS_END); grid = -1; return; }
        int dev = 0, cus = 0, per_cu = 0;
        if (hipGetDevice(&dev) != hipSuccess || hipDeviceGetAttribute(&cus, hipDeviceAttributeMultiprocessorCount, dev) != hipSuccess) { grid = -1; return; }
        if (hipFuncSetAttribute((const void*)trunk_fwd, hipFuncAttributeMaxDynamicSharedMemorySize, LDS_BYTES) != hipSuccess) { fprintf(stderr, "kernel_launch: hipFuncSetAttribute failed\n"); grid = -1; return; }
        if (hipOccupancyMaxActiveBlocksPerMultiprocessor(&per_cu, (const void*)trunk_fwd, NTHR, LDS_BYTES) != hipSuccess || per_cu < 1) { fprintf(stderr, "kernel_launch: occupancy query says %d\n", per_cu); (void)hipGetLastError(); per_cu = 1; }
        grid = cus;
        if (grid > 256) grid = 256;
    }
    if (grid < 0) return;
    (void)hipMemsetAsync((char*)d_ws + WS_CTL, 0, CTL_ZERO_BYTES, stream);
    Args a{};
    for (int i = 0; i < 26; ++i) a.in[i] = (const float*)d_in[i];
    a.out = (float*)d_out; a.ws = (unsigned char*)d_ws; a.pad = 0;
#if MK_N_LAUNCHES == 1
    a.ph_lo = 0; a.ph_hi = N_PHASES; a.one = 1;
    hipLaunchKernelGGL(trunk_fwd, dim3(grid), dim3(NTHR), LDS_BYTES, stream, a);
#else
    for (int p = 0; p < N_PHASES; ++p) { a.ph_lo = p; a.ph_hi = p + 1; a.one = 0; hipLaunchKernelGGL(trunk_fwd, dim3(grid), dim3(NTHR), LDS_BYTES, stream, a); }
#endif
}
```

```cpp
#include <hip/hip_runtime.h>
#include <cstdio>
#include <cstdint>
namespace pg8 {
#define PG8_LAS __attribute__((address_space(3)))
typedef unsigned short bf16_t;
typedef short bf16x8 __attribute__((ext_vector_type(8)));
typedef float f32x4 __attribute__((ext_vector_type(4)));
typedef unsigned u32x4 __attribute__((ext_vector_type(4)));
constexpr int BM = 256, BK = 64, HALF = 128, HTB = HALF * BK * 2  , STAGE_BYTES = 8 * HTB, NXCD = 8, WGM = 8;

__host__ __device__ __forceinline__ int lds_byte(int r, int c) { const int st = (r >> 4) * 2 + (c >> 5), rr = r & 15, cc = c & 31, ob = rr * 64 + cc * 2; return st * 1024 + (ob ^ (((ob >> 9) & 1) << 5)); }
__host__ __device__ __forceinline__ void stage_rc(int b, int& R, int& C) { const int st = b / 1024, sb = b % 1024, swz = sb ^ (((sb >> 9) & 1) << 5); R = (st >> 1) * 16 + swz / 64; C = (st & 1) * 32 + (swz % 64) / 2; }
__host__ __device__ __forceinline__ int perm32(int rho) { const int n = rho >> 4, i = rho & 15; return 8 * (i >> 2) + 4 * n + (i & 3); }

struct Unit { int pm, pn; };
struct Gemm { const bf16_t* A; const bf16_t* Bt; int M, N, K; };

struct StaticOrder {
    int nM, nN, nwg, G, c;
    __host__ __device__ void init(int M, int N, int G_, int c_) { nM = M / BM; nN = N / BM; nwg = nM * nN; G = G_; c = c_; }
    __host__ __device__ __forceinline__ bool next(int i, Unit& u) const {
        const long L = (long)i * G + c; if (L >= nwg) return false;
        int wgid = (int)L; { const int q = nwg / NXCD, r = nwg % NXCD, xcd = wgid % NXCD, off = wgid / NXCD; wgid = (xcd < r ? xcd * (q + 1) : r * (q + 1) + (xcd - r) * q) + off; }
        const int nig = WGM * nN, gid = wgid / nig, fm = gid * WGM, gsz = (nM - fm) < WGM ? (nM - fm) : WGM;
        u.pm = fm + ((wgid % nig) % gsz); u.pn = (wgid % nig) / gsz; return true;
    }
    __device__ __forceinline__ void a_ready(const Unit&) const {}
    __device__ __forceinline__ void done(const Unit&) const {}
};

struct TailOrder {
    int nM, nN, nwg, first, per, c;
    __host__ __device__ void init(int M, int N, int first_, int per_, int c_) { nM = M / BM; nN = N / BM; nwg = nM * nN; first = first_; per = per_; c = c_; }
    __host__ __device__ __forceinline__ bool next(int i, Unit& u) const { if (c < first || i >= per) return false; const int id = per * (c - first) + i; if (id >= nwg) return false; u.pm = id / nN; u.pn = id - u.pm * nN; return true; }
    __device__ __forceinline__ void a_ready(const Unit&) const {}
    __device__ __forceinline__ void done(const Unit&) const {}
};

__device__ __forceinline__ unsigned cvt_pk_bf16(float lo, float hi) { unsigned r; asm volatile("v_cvt_pk_bf16_f32 %0, %1, %2" : "=v"(r) : "v"(lo), "v"(hi)); return r; }
typedef float f32x2 __attribute__((ext_vector_type(2)));
constexpr float RMS_EPS = 1e-6f;
__device__ __forceinline__ float sigm(float v) { return __builtin_amdgcn_rcpf(1.0f + __builtin_amdgcn_exp2f(-1.4426950408889634f * v)); }
__device__ __forceinline__ f32x4 sigm4(const f32x4 v) { const f32x4 t = v * -1.4426950408889634f; f32x4 e;
#pragma unroll
    for (int j = 0; j < 4; ++j) e[j] = __builtin_amdgcn_exp2f(t[j]);
    const f32x4 d = e + 1.0f; f32x4 r;
#pragma unroll
    for (int j = 0; j < 4; ++j) r[j] = __builtin_amdgcn_rcpf(d[j]);
    return r; }
__device__ __forceinline__ f32x4 sexp4s(const f32x4 t, const float inv_s) { f32x4 e;
#pragma unroll
    for (int j = 0; j < 4; ++j) e[j] = __builtin_amdgcn_exp2f(t[j]);
    const f32x4 d = e * inv_s + inv_s; f32x4 r;
#pragma unroll
    for (int j = 0; j < 4; ++j) r[j] = __builtin_amdgcn_rcpf(d[j]);
    return r; }
__device__ __forceinline__ f32x4 sigm4s(const f32x4 v, const float inv_s) { const f32x4 t = v * -1.4426950408889634f; f32x4 e;
#pragma unroll
    for (int j = 0; j < 4; ++j) e[j] = __builtin_amdgcn_exp2f(t[j]);
    const f32x4 d = e * inv_s + inv_s; f32x4 r;
#pragma unroll
    for (int j = 0; j < 4; ++j) r[j] = __builtin_amdgcn_rcpf(d[j]);
    return r; }
__device__ __forceinline__ float bf_lo(unsigned w) { return __uint_as_float(w << 16); }
__device__ __forceinline__ float bf_hi(unsigned w) { return __uint_as_float(w & 0xffff0000u); }
__device__ __forceinline__ float row_rstd(const float* part, size_t row, int fq, float inv_k) {
    const f32x4 a = *(const f32x4*)(part + row * 32 + fq * 8), b = *(const f32x4*)(part + row * 32 + fq * 8 + 4);
    float s = ((a[0] + a[1]) + (a[2] + a[3])) + ((b[0] + b[1]) + (b[2] + b[3]));
    s += __shfl_xor(s, 16); s += __shfl_xor(s, 32);
    return __builtin_amdgcn_rsqf(s * inv_k + RMS_EPS);
}
__device__ __forceinline__ void row_rstd8(float (&rs)[2][4], const float* part, int row0, int fq, float inv_k) {
    f32x4 a[2][4], b[2][4];
#pragma unroll
    for (int ai = 0; ai < 2; ++ai)
#pragma unroll
        for (int m = 0; m < 4; ++m) { const float* p = part + (size_t)(row0 + ai * HALF + m * 16) * 32 + fq * 8; a[ai][m] = *(const f32x4*)p; b[ai][m] = *(const f32x4*)(p + 4); }
#pragma unroll
    for (int ai = 0; ai < 2; ++ai)
#pragma unroll
        for (int m = 0; m < 4; ++m) { float s = ((a[ai][m][0] + a[ai][m][1]) + (a[ai][m][2] + a[ai][m][3])) + ((b[ai][m][0] + b[ai][m][1]) + (b[ai][m][2] + b[ai][m][3]));
            s += __shfl_xor(s, 16); s += __shfl_xor(s, 32); rs[ai][m] = __builtin_amdgcn_rsqf(s * inv_k + RMS_EPS); }
}
__device__ __forceinline__ void row_rstd4(float (&rs)[4], const float* part, int rowb, int fq, float inv_k) {
    f32x4 a[4], b[4];
#pragma unroll
    for (int m = 0; m < 4; ++m) { const float* p = part + (size_t)(rowb + m * 16) * 32 + fq * 8; a[m] = *(const f32x4*)p; b[m] = *(const f32x4*)(p + 4); }
#pragma unroll
    for (int m = 0; m < 4; ++m) { float s = ((a[m][0] + a[m][1]) + (a[m][2] + a[m][3])) + ((b[m][0] + b[m][1]) + (b[m][2] + b[m][3]));
        s += __shfl_xor(s, 16); s += __shfl_xor(s, 32); rs[m] = __builtin_amdgcn_rsqf(s * inv_k + RMS_EPS); }
}
struct EpiZ {
    static constexpr bool PERM = true, AFTER_DRAIN = false, PERMA = false, SEGS = false;
    bf16_t* O; int ldc; const float* rowss; float inv_k; const float* bias; int sig_lo, sig_hi, ga_pn; float* ga;
    __device__ __forceinline__ void operator()(const f32x4 (&acc)[2][2][4][2], const Unit& u, int wr, int wc, int fr, int fq) const {
        const int row0 = u.pm * BM + wr * 64 + fr, col0 = u.pn * BM + wc * 32 + 8 * fq;
        float rs[2][4];
        if (rowss) row_rstd8(rs, rowss, row0, fq, inv_k);
        else {
#pragma unroll
            for (int ai = 0; ai < 2; ++ai)
#pragma unroll
                for (int m = 0; m < 4; ++m) rs[ai][m] = 1.0f; }
        if (u.pn == ga_pn) {
            if (wc == 0 && fq < 2) {
#pragma unroll
                for (int ai = 0; ai < 2; ++ai)
#pragma unroll
                    for (int m = 0; m < 4; ++m) { float* gp = ga + (size_t)(row0 + ai * HALF + m * 16) * 16 + 8 * fq;
                        *(f32x4*)gp = acc[ai][0][m][0] * rs[ai][m]; *(f32x4*)(gp + 4) = acc[ai][0][m][1] * rs[ai][m]; }
            }
            return;
        }
        const bool sg = (u.pn >= sig_lo) && (u.pn < sig_hi);
        f32x4 bv[2][2];
#pragma unroll
        for (int bj = 0; bj < 2; ++bj)
#pragma unroll
            for (int n = 0; n < 2; ++n) bv[bj][n] = sg ? *(const f32x4*)(bias + (col0 - sig_lo * BM) + bj * HALF + 4 * n) : (f32x4){0.f, 0.f, 0.f, 0.f};
#pragma unroll
        for (int ai = 0; ai < 2; ++ai)
#pragma unroll
            for (int m = 0; m < 4; ++m) { bf16_t* rowp = O + (size_t)(row0 + ai * HALF + m * 16) * ldc + col0; const float r = rs[ai][m];
#pragma unroll
                for (int bj = 0; bj < 2; ++bj) { f32x4 v0 = acc[ai][bj][m][0] * r + bv[bj][0], v1 = acc[ai][bj][m][1] * r + bv[bj][1];
                    if (sg) {
                        { v0 = sigm4(v0); v1 = sigm4(v1); } }
                    u32x4 w; w.x = cvt_pk_bf16(v0[0], v0[1]); w.y = cvt_pk_bf16(v0[2], v0[3]); w.z = cvt_pk_bf16(v1[0], v1[1]); w.w = cvt_pk_bf16(v1[2], v1[3]);
                    *(u32x4*)(rowp + bj * HALF) = w; } }
    }
};
struct EpiIn {
    static constexpr bool PERM = true, AFTER_DRAIN = false, PERMA = false, SEGS = false;
    bf16_t* Z; int ldc; bf16_t* aglu; const float* rowss; float inv_k; const float* bgate; float* ga; const float* qg; const float* kg; PG8_LAS float* xl; bf16_t* qkv; int seq; const PG8_LAS float* rt; const PG8_LAS int* slot;
    __device__ __forceinline__ void operator()(const f32x4 (&acc)[2][2][4][2], const Unit& u, int wr, int wc, int fr, int fq) const {
        const int row0 = u.pm * BM + wr * 64 + fr, col0 = u.pn * BM + wc * 32 + 8 * fq, pn = u.pn;
        float rs[2][4];
        { const PG8_LAS float* rp = rt + slot[u.pm] * BM + wr * 64 + fr;
#pragma unroll
          for (int ai = 0; ai < 2; ++ai)
#pragma unroll
              for (int m = 0; m < 4; ++m) rs[ai][m] = rp[ai * HALF + m * 16]; }
        if (pn == 46) {
            if (wc == 0 && fq < 2) {
#pragma unroll
                for (int ai = 0; ai < 2; ++ai)
#pragma unroll
                    for (int m = 0; m < 4; ++m) { float* gp = ga + (size_t)(row0 + ai * HALF + m * 16) * 16 + 8 * fq;
                        *(f32x4*)gp = acc[ai][0][m][0] * rs[ai][m]; *(f32x4*)(gp + 4) = acc[ai][0][m][1] * rs[ai][m]; }
            }
            return;
        }
        if (pn < 4) {
            const int ch0 = pn * HALF + wc * 32 + 8 * fq;
#pragma unroll
            for (int ai = 0; ai < 2; ++ai)
#pragma unroll
                for (int m = 0; m < 4; ++m) { const float r = rs[ai][m]; f32x4 a0 = acc[ai][0][m][0] * r, a1 = acc[ai][0][m][1] * r; const f32x4 g0 = acc[ai][1][m][0] * r, g1 = acc[ai][1][m][1] * r;
                    { a0 *= sigm4(g0); a1 *= sigm4(g1); }
                    u32x4 w; w.x = cvt_pk_bf16(a0[0], a0[1]); w.y = cvt_pk_bf16(a0[2], a0[3]); w.z = cvt_pk_bf16(a1[0], a1[1]); w.w = cvt_pk_bf16(a1[2], a1[3]);
                    *(u32x4*)(aglu + (size_t)(row0 + ai * HALF + m * 16) * 512 + ch0) = w; }
            return;
        }
        if (pn >= 10 && pn < 18) {
            const bool isk = pn >= 14;
#pragma unroll
            for (int ai = 0; ai < 2; ++ai)
#pragma unroll
                for (int m = 0; m < 4; ++m)
#pragma unroll
                    for (int bj = 0; bj < 2; ++bj) { const f32x4 a = acc[ai][bj][m][0], b = acc[ai][bj][m][1];
                        float s = ((a[0] * a[0] + a[1] * a[1]) + (a[2] * a[2] + a[3] * a[3])) + ((b[0] * b[0] + b[1] * b[1]) + (b[2] * b[2] + b[3] * b[3]));
                        s += __shfl_xor(s, 16); s += __shfl_xor(s, 32);
                        if (fq == 0) xl[(ai * HALF + wr * 64 + m * 16 + fr) * 8 + bj * 4 + wc] = s * (rs[ai][m] * rs[ai][m]); }
            asm volatile("s_waitcnt lgkmcnt(0)" ::: "memory"); __builtin_amdgcn_s_barrier(); asm volatile("" ::: "memory");
            const float* gp = (isk ? kg : qg) + wc * 32 + 8 * fq;
            const f32x4 gn0 = *(const f32x4*)gp, gn1 = *(const f32x4*)(gp + 4);
#pragma unroll
            for (int ai = 0; ai < 2; ++ai)
#pragma unroll
                for (int m = 0; m < 4; ++m) { const int rl = ai * HALF + wr * 64 + m * 16 + fr; const f32x4 p0 = *(const PG8_LAS f32x4*)(xl + rl * 8), p1 = *(const PG8_LAS f32x4*)(xl + rl * 8 + 4);
                    const float t0 = (p0[0] + p0[1]) + (p0[2] + p0[3]), t1 = (p1[0] + p1[1]) + (p1[2] + p1[3]);
                    const float r0 = __builtin_amdgcn_rsqf(t0 * (1.0f / 128.0f) + RMS_EPS) * rs[ai][m], r1 = __builtin_amdgcn_rsqf(t1 * (1.0f / 128.0f) + RMS_EPS) * rs[ai][m];
                    const int grow = row0 + ai * HALF + m * 16, bb = grow / seq, tt = grow - bb * seq;
                    bf16_t* rowp = qkv + ((size_t)((isk ? 1 : 0) * (2 * 8) + bb * 8 + 2 * (pn - (isk ? 14 : 10))) * seq + tt) * 128 + wc * 32 + 8 * fq;
#pragma unroll
                    for (int bj = 0; bj < 2; ++bj) { const float r = bj ? r1 : r0; const f32x4 v0 = acc[ai][bj][m][0] * r * gn0, v1 = acc[ai][bj][m][1] * r * gn1;
                        u32x4 w; w.x = cvt_pk_bf16(v0[0], v0[1]); w.y = cvt_pk_bf16(v0[2], v0[3]); w.z = cvt_pk_bf16(v1[0], v1[1]); w.w = cvt_pk_bf16(v1[2], v1[3]);
                        *(u32x4*)(rowp + (size_t)bj * seq * 128) = w; } }
            return;
        }
        if (pn >= 22) {
            unsigned char* g8 = (unsigned char*)Z + 580911104ll;
            f32x4 bv[2][2];
#pragma unroll
            for (int bj = 0; bj < 2; ++bj)
#pragma unroll
                for (int n = 0; n < 2; ++n) bv[bj][n] = *(const f32x4*)(bgate + (col0 - 22 * BM) + bj * HALF + 4 * n) * -1.4426950408889634f;
#pragma unroll
            for (int ai = 0; ai < 2; ++ai)
#pragma unroll
                for (int m = 0; m < 4; ++m) { const int grow = row0 + ai * HALF + m * 16; const float rn = rs[ai][m] * -1.4426950408889634f;
#pragma unroll
                    for (int bj = 0; bj < 2; ++bj) { const f32x4 v0 = sexp4s(acc[ai][bj][m][0] * rn + bv[bj][0], 1.0f / 255.0f), v1 = sexp4s(acc[ai][bj][m][1] * rn + bv[bj][1], 1.0f / 255.0f);
                        unsigned w0 = 0u, w1 = 0u;
                        w0 = __builtin_amdgcn_cvt_pk_u8_f32(v0[0], 0, w0); w0 = __builtin_amdgcn_cvt_pk_u8_f32(v0[1], 1, w0); w0 = __builtin_amdgcn_cvt_pk_u8_f32(v0[2], 2, w0); w0 = __builtin_amdgcn_cvt_pk_u8_f32(v0[3], 3, w0);
                        w1 = __builtin_amdgcn_cvt_pk_u8_f32(v1[0], 0, w1); w1 = __builtin_amdgcn_cvt_pk_u8_f32(v1[1], 1, w1); w1 = __builtin_amdgcn_cvt_pk_u8_f32(v1[2], 2, w1); w1 = __builtin_amdgcn_cvt_pk_u8_f32(v1[3], 3, w1);
                        typedef unsigned u32x2g __attribute__((ext_vector_type(2)));
                        *(u32x2g*)(g8 + (size_t)grow * 6144 + (col0 - 22 * BM) + bj * HALF) = (u32x2g){w0, w1}; } }
            return;
        }
        const bool sg = false;
        f32x4 bv[2][2];
#pragma unroll
        for (int bj = 0; bj < 2; ++bj)
#pragma unroll
            for (int n = 0; n < 2; ++n) bv[bj][n] = sg ? *(const f32x4*)(bgate + (col0 - 22 * BM) + bj * HALF + 4 * n) : (f32x4){0.f, 0.f, 0.f, 0.f};
#pragma unroll
        for (int ai = 0; ai < 2; ++ai)
#pragma unroll
            for (int m = 0; m < 4; ++m) { const int grow = row0 + ai * HALF + m * 16, bb = grow / seq, tt = grow - bb * seq; const bool isv = pn >= 18 && pn < 22;
                bf16_t* rowp = isv ? qkv + ((size_t)(2 * (2 * 8) + bb * 8 + 2 * (pn - 18)) * seq + tt) * 128 + wc * 32 + 8 * fq : Z + (size_t)grow * ldc + col0; const size_t bjs = isv ? (size_t)seq * 128 : (size_t)HALF; const float r = rs[ai][m];
#pragma unroll
                for (int bj = 0; bj < 2; ++bj) { f32x4 v0 = acc[ai][bj][m][0] * r + bv[bj][0], v1 = acc[ai][bj][m][1] * r + bv[bj][1];
                    if (sg) {
                        { v0 = sigm4(v0); v1 = sigm4(v1); } }
                    u32x4 w; w.x = cvt_pk_bf16(v0[0], v0[1]); w.y = cvt_pk_bf16(v0[2], v0[3]); w.z = cvt_pk_bf16(v1[0], v1[1]); w.w = cvt_pk_bf16(v1[2], v1[3]);
                    *(u32x4*)(rowp + bj * bjs) = w; } }
    }
};
template <int CTRL, bool BC> __device__ __forceinline__ float dppf(float old, float src) { return __builtin_bit_cast(float, __builtin_amdgcn_update_dpp(__builtin_bit_cast(int, old), __builtin_bit_cast(int, src), CTRL, 0xf, 0xf, BC)); }
__device__ __forceinline__ f32x4 prev_row1(const f32x4 xm, const f32x4 xm1) { f32x4 r;
#pragma unroll
    for (int j = 0; j < 4; ++j) r[j] = dppf<0x111, false>(dppf<0x10F, true>(0.f, xm1[j]), xm[j]);
    return r; }
__device__ __forceinline__ f32x4 prev_row2(const f32x4 xm, const f32x4 xm1) { f32x4 r;
#pragma unroll
    for (int j = 0; j < 4; ++j) r[j] = dppf<0x112, false>(dppf<0x10E, true>(0.f, xm1[j]), xm[j]);
    return r; }
struct EpiFfn {
    static constexpr bool PERM = true, AFTER_DRAIN = false, PERMA = true, SEGS = false;
    bf16_t* A; int ff; const float* fw; float* edge; const PG8_LAS float* rt; const PG8_LAS int* slot; PG8_LAS float* hx;
    __device__ __forceinline__ void operator()(const f32x4 (&acc)[2][2][4][2], const Unit& u, int wr, int wc, int fr, int fq) const {
        typedef unsigned u32x2 __attribute__((ext_vector_type(2)));
        const int rowg = u.pm * BM + wr * 64, ch0 = u.pn * HALF + wc * 32 + 8 * fq, colt = u.pn * BM + wc * 32 + 8 * fq, coll = wc * 32 + 8 * fq; const int ff2 = 2 * ff;
        float rs[2][4];
        { const PG8_LAS float* rp = rt + slot[u.pm] * BM + wr * 64 + 4 * fr;
#pragma unroll
          for (int ai = 0; ai < 2; ++ai)
#pragma unroll
              for (int m = 0; m < 4; ++m) rs[ai][m] = rp[ai * HALF + m]; }
        if (fr == 15) {
#pragma unroll
            for (int n = 0; n < 2; ++n)
#pragma unroll
                for (int ai = 0; ai < 2; ++ai) { const int g = ai * 2 + wr;
                    const f32x4 g2 = acc[ai][0][2][n] * rs[ai][2], g3 = acc[ai][0][3][n] * rs[ai][3], v2 = acc[ai][1][2][n] * rs[ai][2], v3 = acc[ai][1][3][n] * rs[ai][3];
                    if (g < 3) { PG8_LAS float* hp = hx + (g * 2) * 256 + coll + 4 * n;
                        *(PG8_LAS f32x4*)hp = g2; *(PG8_LAS f32x4*)(hp + 128) = v2; *(PG8_LAS f32x4*)(hp + 256) = g3; *(PG8_LAS f32x4*)(hp + 256 + 128) = v3; }
                    else { float* ep = edge + (size_t)(u.pm * 4 + 3) * 4 * ff2 + colt + 4 * n;
                        *(f32x4*)(ep) = g2; *(f32x4*)(ep + HALF) = v2; *(f32x4*)(ep + (size_t)ff2) = g3; *(f32x4*)(ep + (size_t)ff2 + HALF) = v3; } }
        }
        if (fr == 0 && wr == 0) {
#pragma unroll
            for (int n = 0; n < 2; ++n) { float* ep = edge + (size_t)(u.pm * 4) * 4 * ff2 + colt + 4 * n;
                *(f32x4*)(ep + (size_t)2 * ff2) = acc[0][0][0][n] * rs[0][0]; *(f32x4*)(ep + (size_t)2 * ff2 + HALF) = acc[0][1][0][n] * rs[0][0];
                *(f32x4*)(ep + (size_t)3 * ff2) = acc[0][0][1][n] * rs[0][1]; *(f32x4*)(ep + (size_t)3 * ff2 + HALF) = acc[0][1][1][n] * rs[0][1]; }
        }
        asm volatile("s_waitcnt lgkmcnt(0)" ::: "memory"); __builtin_amdgcn_s_barrier(); asm volatile("" ::: "memory");
        u32x2 w0s[2][4];
#pragma unroll
        for (int n = 0; n < 2; ++n) {
            f32x4 wg[3], wv[3];
#pragma unroll
            for (int j = 0; j < 3; ++j) { wg[j] = *(const f32x4*)(fw + (size_t)j * ff2 + ch0 + 4 * n); wv[j] = *(const f32x4*)(fw + (size_t)j * ff2 + ff + ch0 + 4 * n); }
#pragma unroll
            for (int ai = 0; ai < 2; ++ai) { const int g = ai * 2 + wr;
                f32x4 xg[4], xv[4];
#pragma unroll
                for (int m = 0; m < 4; ++m) { xg[m] = acc[ai][0][m][n] * rs[ai][m]; xv[m] = acc[ai][1][m][n] * rs[ai][m]; }
                f32x4 pg2, pg3, pv2, pv3;
#pragma unroll
                for (int j = 0; j < 4; ++j) { pg2[j] = dppf<0x111, true>(0.f, xg[2][j]); pg3[j] = dppf<0x111, true>(0.f, xg[3][j]); pv2[j] = dppf<0x111, true>(0.f, xv[2][j]); pv3[j] = dppf<0x111, true>(0.f, xv[3][j]); }
                if (fr == 0 && g > 0) { const PG8_LAS float* hp = hx + ((g - 1) * 2) * 256 + coll + 4 * n;
                    pg2 = *(const PG8_LAS f32x4*)hp; pv2 = *(const PG8_LAS f32x4*)(hp + 128); pg3 = *(const PG8_LAS f32x4*)(hp + 256); pv3 = *(const PG8_LAS f32x4*)(hp + 256 + 128); }
#pragma unroll
                for (int m = 0; m < 4; ++m) {
                    const f32x4 g2 = m >= 2 ? xg[m - 2] : (m == 1 ? pg3 : pg2), g1 = m >= 1 ? xg[m - 1] : pg3;
                    const f32x4 v2 = m >= 2 ? xv[m - 2] : (m == 1 ? pv3 : pv2), v1 = m >= 1 ? xv[m - 1] : pv3;
                    const f32x4 ug = wg[0] * g2 + wg[1] * g1 + wg[2] * xg[m];
                    const f32x4 uv = wv[0] * v2 + wv[1] * v1 + wv[2] * xv[m];
                    const f32x4 aw = ug * sigm4(ug) * uv; u32x2 w; w.x = cvt_pk_bf16(aw[0], aw[1]); w.y = cvt_pk_bf16(aw[2], aw[3]);
                    if (n == 0) w0s[ai][m] = w;
                    else if (m >= 2 || fr > 0 || g > 0) *(u32x4*)(A + (size_t)(rowg + ai * HALF + 4 * fr + m) * ff + ch0) = (u32x4){w0s[ai][m].x, w0s[ai][m].y, w.x, w.y}; }
            }
        }
    }
};
template <int MODE> struct EpiMerge {
    static constexpr bool PERM = true, AFTER_DRAIN = false, PERMA = false, SEGS = false;
    const bf16_t* G; int ldg, gcol0; bf16_t* tmp; bf16_t* mrg; int ldt;
    __device__ __forceinline__ void operator()(const f32x4 (&acc)[2][2][4][2], const Unit& u, int wr, int wc, int fr, int fq) const {
        const int row0 = u.pm * BM + wr * 64 + fr, col0 = u.pn * BM + wc * 32 + 8 * fq;
#pragma unroll
        for (int ai = 0; ai < 2; ++ai) {
            u32x4 gw[4][2], tw[4][2];
#pragma unroll
            for (int m = 0; m < 4; ++m)
#pragma unroll
                for (int bj = 0; bj < 2; ++bj) { const size_t row = (size_t)(row0 + ai * HALF + m * 16); const int col = col0 + bj * HALF;
                    gw[m][bj] = *(const u32x4*)(G + row * ldg + gcol0 + col); if (MODE >= 1) tw[m][bj] = *(const u32x4*)(tmp + row * ldt + col); }
#pragma unroll
            for (int m = 0; m < 4; ++m)
#pragma unroll
                for (int bj = 0; bj < 2; ++bj) { const size_t row = (size_t)(row0 + ai * HALF + m * 16); const int col = col0 + bj * HALF; const u32x4 g = gw[m][bj];
                    f32x4 v0 = acc[ai][bj][m][0] * (f32x4){bf_lo(g.x), bf_hi(g.x), bf_lo(g.y), bf_hi(g.y)};
                    f32x4 v1 = acc[ai][bj][m][1] * (f32x4){bf_lo(g.z), bf_hi(g.z), bf_lo(g.w), bf_hi(g.w)};
                    if (MODE >= 1) { const u32x4 t = tw[m][bj]; v0 += (f32x4){bf_lo(t.x), bf_hi(t.x), bf_lo(t.y), bf_hi(t.y)}; v1 += (f32x4){bf_lo(t.z), bf_hi(t.z), bf_lo(t.w), bf_hi(t.w)}; }
                    u32x4 w; w.x = cvt_pk_bf16(v0[0], v0[1]); w.y = cvt_pk_bf16(v0[2], v0[3]); w.z = cvt_pk_bf16(v1[0], v1[1]); w.w = cvt_pk_bf16(v1[2], v1[3]);
                    if (MODE <= 1) *(u32x4*)(tmp + row * ldt + col) = w; else *(u32x4*)(mrg + row * ldt + col) = w; }
        }
    }
};
struct EpiMerge3 {
    static constexpr bool PERM = true, AFTER_DRAIN = false, PERMA = false, SEGS = true; static constexpr int SEG1 = 8, SEG2 = 16;
    typedef unsigned u32x2q __attribute__((ext_vector_type(2)));
    const unsigned char* G; int ldg, gcol0; bf16_t* mrg; int ldt;
    static __device__ __forceinline__ f32x4 un4(const unsigned w) { return (f32x4){(float)(w & 255u), (float)((w >> 8) & 255u), (float)((w >> 16) & 255u), (float)(w >> 24)}; }
    static __device__ __forceinline__ f32x4 clamp4(f32x4 v) {
#pragma unroll
        for (int j = 0; j < 4; ++j) v[j] = fmaxf(v[j], 1e-9f);
        return v; }
    static __device__ __forceinline__ f32x4 rcp4(const f32x4 v) { f32x4 r;
#pragma unroll
        for (int j = 0; j < 4; ++j) r[j] = __builtin_amdgcn_rcpf(v[j]);
        return r; }
    __device__ __forceinline__ void rescale(f32x4 (&acc)[2][2][4][2], const Unit& u, int t, int wr, int wc, int fr, int fq) const {
        int row0 = u.pm * BM + wr * 64 + fr, col0 = u.pn * BM + wc * 32 + 8 * fq; const int bp = (t == SEG1) ? 0 : 1;
        asm volatile("" : "+v"(row0), "+v"(col0));
        const unsigned char* gb = G + (size_t)row0 * ldg + gcol0 + bp * 2048 + col0;
        u32x2q gp[2][4][2], gn[2][4][2];
#pragma unroll
        for (int ai = 0; ai < 2; ++ai)
#pragma unroll
            for (int m = 0; m < 4; ++m)
#pragma unroll
                for (int bj = 0; bj < 2; ++bj) { const unsigned char* p = gb + (size_t)(ai * HALF + m * 16) * ldg + bj * HALF; gp[ai][m][bj] = *(const u32x2q*)p; gn[ai][m][bj] = *(const u32x2q*)(p + 2048); }
#pragma unroll
        for (int ai = 0; ai < 2; ++ai)
#pragma unroll
            for (int m = 0; m < 4; ++m)
#pragma unroll
                for (int bj = 0; bj < 2; ++bj) {
                    acc[ai][bj][m][0] *= clamp4(un4(gp[ai][m][bj].x)) * rcp4(clamp4(un4(gn[ai][m][bj].x)));
                    acc[ai][bj][m][1] *= clamp4(un4(gp[ai][m][bj].y)) * rcp4(clamp4(un4(gn[ai][m][bj].y))); }
    }
    __device__ __forceinline__ void operator()(const f32x4 (&acc)[2][2][4][2], const Unit& u, int wr, int wc, int fr, int fq) const {
        const int row0 = u.pm * BM + wr * 64 + fr, col0 = u.pn * BM + wc * 32 + 8 * fq;
        u32x2q gw[2][4][2];
#pragma unroll
        for (int ai = 0; ai < 2; ++ai)
#pragma unroll
            for (int m = 0; m < 4; ++m)
#pragma unroll
                for (int bj = 0; bj < 2; ++bj) gw[ai][m][bj] = *(const u32x2q*)(G + (size_t)(row0 + ai * HALF + m * 16) * ldg + gcol0 + 2 * 2048 + col0 + bj * HALF);
#pragma unroll
        for (int ai = 0; ai < 2; ++ai)
#pragma unroll
            for (int m = 0; m < 4; ++m)
#pragma unroll
                for (int bj = 0; bj < 2; ++bj) { const f32x4 v0 = acc[ai][bj][m][0] * (clamp4(un4(gw[ai][m][bj].x)) * (1.0f / 255.0f)), v1 = acc[ai][bj][m][1] * (clamp4(un4(gw[ai][m][bj].y)) * (1.0f / 255.0f));
                    u32x4 w; w.x = cvt_pk_bf16(v0[0], v0[1]); w.y = cvt_pk_bf16(v0[2], v0[3]); w.z = cvt_pk_bf16(v1[0], v1[1]); w.w = cvt_pk_bf16(v1[2], v1[3]);
                    *(u32x4*)(mrg + (size_t)(row0 + ai * HALF + m * 16) * ldt + col0 + bj * HALF) = w; }
    }
};
template <bool PLE> struct EpiRes {
    static constexpr bool PERM = true, AFTER_DRAIN = false, PERMA = false, SEGS = false;
    const bf16_t* hi_in; bf16_t* hi_out; float* xout_f; float* rowss_out; const float* rowss_in; float inv_k; const bf16_t* pe; int ld;
    __device__ __forceinline__ void operator()(const f32x4 (&acc)[2][2][4][2], const Unit& u, int wr, int wc, int fr, int fq) const {
        const int row0 = u.pm * BM + wr * 64 + fr, col0 = u.pn * BM + wc * 32 + 8 * fq; constexpr int NB = PLE ? 2 : 4; constexpr bool PF = !PLE;
        float rs[2][4];
        if (PLE) { row_rstd4(rs[0], rowss_in, row0, fq, inv_k); row_rstd4(rs[1], rowss_in, row0 + HALF, fq, inv_k); }
        constexpr int NBT = 2 * (4 / NB);
        u32x4 xh[PF ? 2 : 1][NB][2], pw[PF ? 2 : 1][NB][2];
#define PG8_RES_LOAD(bi_, buf_) do { _Pragma("unroll") for (int mm = 0; mm < NB; ++mm) _Pragma("unroll") for (int bj = 0; bj < 2; ++bj) { \
            const size_t off = (size_t)(row0 + ((bi_) / (4 / NB)) * HALF + (NB * ((bi_) % (4 / NB)) + mm) * 16) * ld + col0 + bj * HALF; \
            xh[buf_][mm][bj] = *(const u32x4*)(hi_in + off); if (PLE) pw[buf_][mm][bj] = *(const u32x4*)(pe + off); } } while (0)
        if (PF) PG8_RES_LOAD(0, 0);
#pragma unroll
        for (int bi = 0; bi < NBT; ++bi) { const int ai = bi / (4 / NB), mh = bi % (4 / NB), buf = PF ? (bi & 1) : 0;
            if (PF) { if (bi + 1 < NBT) PG8_RES_LOAD(bi + 1, (bi + 1) & 1); } else PG8_RES_LOAD(bi, 0);
            __builtin_amdgcn_sched_barrier(0);
#pragma unroll
                for (int mm = 0; mm < NB; ++mm) { const int m = NB * mh + mm; const size_t row = (size_t)(row0 + ai * HALF + m * 16); float ss = 0.f;
                    const float r = PLE ? rs[ai][m] : 1.0f;
#pragma unroll
                    for (int bj = 0; bj < 2; ++bj) { const size_t off = row * ld + col0 + bj * HALF;
                        f32x4 v0 = acc[ai][bj][m][0], v1 = acc[ai][bj][m][1];
                        if (PLE) { const u32x4 p = pw[buf][mm][bj];
                            { v0 = sigm4(v0 * r); v1 = sigm4(v1 * r); }
                            v0 *= (f32x4){bf_lo(p.x), bf_hi(p.x), bf_lo(p.y), bf_hi(p.y)}; v1 *= (f32x4){bf_lo(p.z), bf_hi(p.z), bf_lo(p.w), bf_hi(p.w)}; }
                        const u32x4 h = xh[buf][mm][bj];
                        const f32x4 x0 = (f32x4){bf_lo(h.x), bf_hi(h.x), bf_lo(h.y), bf_hi(h.y)} + v0;
                        const f32x4 x1 = (f32x4){bf_lo(h.z), bf_hi(h.z), bf_lo(h.w), bf_hi(h.w)} + v1;
                        u32x4 w; w.x = cvt_pk_bf16(x0[0], x0[1]); w.y = cvt_pk_bf16(x0[2], x0[3]); w.z = cvt_pk_bf16(x1[0], x1[1]); w.w = cvt_pk_bf16(x1[2], x1[3]);
                        if (xout_f) { *(f32x4*)(xout_f + off) = x0; *(f32x4*)(xout_f + off + 4) = x1; }
                        else *(u32x4*)(hi_out + off) = w;
                        ss += (x0[0] * x0[0] + x0[1] * x0[1]) + (x0[2] * x0[2] + x0[3] * x0[3]) + (x1[0] * x1[0] + x1[1] * x1[1]) + (x1[2] * x1[2] + x1[3] * x1[3]); }
                    ss += __shfl_xor(ss, 16); ss += __shfl_xor(ss, 32);
                    if (fq == 0 && !xout_f) rowss_out[row * 32 + u.pn * 4 + wc] = ss; }
        }
#undef PG8_RES_LOAD
    }
};

template <class Epi, class Sched, bool ALIGN_EPI = false, bool SP2 = false>
__device__ __forceinline__ void gemm_phase(PG8_LAS unsigned char* lds, const Gemm g, const Sched& S, const Epi& E) {
    int tid_ = threadIdx.x; asm volatile("" : "+v"(tid_));
    const int tid = tid_, wid = __builtin_amdgcn_readfirstlane(tid >> 6), lane = tid & 63, wr = wid >> 2, wc = wid & 3, fr = lane & 15, fq = lane >> 4;
    const int K = g.K, nt = K / BK;
    unsigned voffA[2], voffB[2];
#pragma unroll
    for (int i = 0; i < 2; ++i) { int R, C; stage_rc(tid * 16 + i * 8192, R, C); const int Rb = Epi::PERM ? ((R & ~31) + perm32(R & 31)) : R;
        const int Ra = Epi::PERMA ? ((R & ~63) + 4 * (R & 15) + ((R >> 4) & 3)) : R;
        voffA[i] = (unsigned)(Ra * K + C) * 2u; voffB[i] = (unsigned)(Rb * K + C) * 2u; }
    const size_t kstep = (size_t)(BK * 2);
    const size_t hstep = (size_t)HALF * K * 2;
    const size_t tstep = 2 * hstep;
    const unsigned ldsw = (unsigned)wid * 1024u;
    const int aoff = lds_byte(wr * 64 + fr, fq * 8), boff = lds_byte(wc * 32 + fr, fq * 8);
#define PG8_SA(b, h) (((b) * 2 + (h)) * HTB)
#define PG8_SB(b, h) ((4 + (b) * 2 + (h)) * HTB)
#define PG8_STAGE(bufoff, gbase, voff) do { _Pragma("unroll") for (int _i = 0; _i < 2; ++_i) \
        __builtin_amdgcn_global_load_lds((const unsigned*)((const char*)(gbase) + (voff)[_i]), (PG8_LAS unsigned*)(lds + (bufoff) + ldsw + _i * 8192), 16, 0, 0); } while (0)
#define PG8_LDA(dst, b, h) do { _Pragma("unroll") for (int m = 0; m < 4; ++m) _Pragma("unroll") for (int k = 0; k < 2; ++k) dst[m][k] = *(const PG8_LAS bf16x8*)(lds + PG8_SA(b, h) + aoff + m * 2048 + k * 1024); } while (0)
#define PG8_LDB(dst, b, h) do { _Pragma("unroll") for (int n = 0; n < 2; ++n) _Pragma("unroll") for (int k = 0; k < 2; ++k) dst[n][k] = *(const PG8_LAS bf16x8*)(lds + PG8_SB(b, h) + boff + n * 2048 + k * 1024); } while (0)
#define PG8_MMA(ai, bj, At, Bt) do { __builtin_amdgcn_s_setprio(1); _Pragma("unroll") for (int m = 0; m < 4; ++m) _Pragma("unroll") for (int n = 0; n < 2; ++n) _Pragma("unroll") for (int k = 0; k < 2; ++k) \
        acc[ai][bj][m][n] = __builtin_amdgcn_mfma_f32_16x16x32_bf16(Bt[n][k], At[m][k], acc[ai][bj][m][n], 0, 0, 0); __builtin_amdgcn_s_setprio(0); } while (0)
#define PG8_WAIT_V(n) asm volatile("s_waitcnt vmcnt(" #n ")" ::: "memory")
#define PG8_WAIT_L(n) asm volatile("s_waitcnt lgkmcnt(" #n ")" ::: "memory")
#define PG8_BAR __builtin_amdgcn_s_barrier()
#define PG8_SCHED __builtin_amdgcn_sched_barrier(0)
    Unit cur, nxt; int ui = 0;
    if (!S.next(0, cur)) return;
    f32x4 acc[2][2][4][2];
#pragma unroll
    for (int a = 0; a < 2; ++a)
#pragma unroll
        for (int b = 0; b < 2; ++b)
#pragma unroll
            for (int m = 0; m < 4; ++m)
#pragma unroll
                for (int n = 0; n < 2; ++n) acc[a][b][m][n] = (f32x4){0.f, 0.f, 0.f, 0.f};
    bf16x8 At[4][2], B0[2][2], B1[2][2];
    const char* cA = (const char*)g.A + (size_t)cur.pm * tstep; const char* cB = (const char*)g.Bt + (size_t)cur.pn * tstep;
    S.a_ready(cur);
    if constexpr (SP2) {
        PG8_STAGE(PG8_SB(0, 0), cB, voffB); PG8_STAGE(PG8_SB(0, 1), cB + hstep, voffB); PG8_STAGE(PG8_SA(0, 0), cA, voffA); PG8_STAGE(PG8_SA(0, 1), cA + hstep, voffA);
        PG8_STAGE(PG8_SB(1, 0), cB + kstep, voffB); PG8_STAGE(PG8_SA(1, 0), cA + kstep, voffA); PG8_STAGE(PG8_SB(1, 1), cB + hstep + kstep, voffB);
        if (wr == 1) PG8_BAR;
        PG8_WAIT_V(8); PG8_BAR;
        PG8_WAIT_V(6); PG8_BAR;
    } else {
        PG8_STAGE(PG8_SB(0, 0), cB, voffB); PG8_STAGE(PG8_SA(0, 0), cA, voffA); PG8_STAGE(PG8_SB(0, 1), cB + hstep, voffB); PG8_STAGE(PG8_SA(0, 1), cA + hstep, voffA);
        if (wr == 1) PG8_BAR;
        PG8_WAIT_V(4); PG8_BAR;
        PG8_STAGE(PG8_SB(1, 0), cB + kstep, voffB); PG8_STAGE(PG8_SA(1, 0), cA + kstep, voffA); PG8_STAGE(PG8_SB(1, 1), cB + hstep + kstep, voffB);
        PG8_WAIT_V(6); PG8_BAR;
    }
    for (;;) {
        const bool has_next = S.next(ui + 1, nxt);
        const char* nA = has_next ? (const char*)g.A + (size_t)nxt.pm * tstep : cA + (size_t)(nt - 2) * kstep; const char* nB = has_next ? (const char*)g.Bt + (size_t)nxt.pn * tstep : cB + (size_t)(nt - 2) * kstep;
        for (int seg = 0; seg < (Epi::SEGS ? 3 : 1); ++seg) {
        int tb = 0, te = nt; if constexpr (Epi::SEGS) { tb = seg == 0 ? 0 : (seg == 1 ? Epi::SEG1 : Epi::SEG2); te = seg == 0 ? Epi::SEG1 : (seg == 1 ? Epi::SEG2 : nt); if (seg) E.rescale(acc, cur, tb, wr, wc, fr, fq); }
        for (int t = tb; t < te; t += 2) {
            const bool last = (t == nt - 2);
            const char* a1 = cA + (size_t)(t + 1) * kstep;
            const char* a2 = last ? nA : cA + (size_t)(t + 2) * kstep; const char* b2 = last ? nB : cB + (size_t)(t + 2) * kstep;
            const char* a3 = a2 + kstep; const char* b3 = b2 + kstep;
            if (last && has_next) S.a_ready(nxt);
            if constexpr (SP2) {
            PG8_LDB(B0, 0, 0); PG8_LDB(B1, 0, 1); PG8_SCHED; PG8_LDA(At, 0, 0); PG8_STAGE(PG8_SA(1, 1), a1 + hstep, voffA);
            PG8_WAIT_V(8); PG8_WAIT_L(0); PG8_BAR; PG8_MMA(0, 0, At, B0); PG8_MMA(0, 1, At, B1); PG8_BAR; PG8_SCHED;
            PG8_LDA(At, 0, 1); PG8_STAGE(PG8_SB(0, 0), b2, voffB); PG8_STAGE(PG8_SB(0, 1), b2 + hstep, voffB); PG8_STAGE(PG8_SA(0, 0), a2, voffA);
            PG8_WAIT_V(8); PG8_WAIT_L(0); PG8_BAR; PG8_MMA(1, 0, At, B0); PG8_MMA(1, 1, At, B1); PG8_BAR; PG8_SCHED;
            PG8_LDB(B0, 1, 0); PG8_LDB(B1, 1, 1); PG8_SCHED; PG8_LDA(At, 1, 0); PG8_STAGE(PG8_SA(0, 1), a2 + hstep, voffA);
            PG8_WAIT_V(8); PG8_WAIT_L(0); PG8_BAR; PG8_MMA(0, 0, At, B0); PG8_MMA(0, 1, At, B1); PG8_BAR; PG8_SCHED;
            PG8_LDA(At, 1, 1); PG8_STAGE(PG8_SB(1, 0), b3, voffB); PG8_STAGE(PG8_SB(1, 1), b3 + hstep, voffB); PG8_STAGE(PG8_SA(1, 0), a3, voffA);
            PG8_WAIT_V(8); PG8_WAIT_L(0); PG8_BAR; PG8_MMA(1, 0, At, B0); PG8_MMA(1, 1, At, B1); PG8_BAR; PG8_SCHED;
            } else {
            PG8_LDB(B0, 0, 0); PG8_SCHED; PG8_LDA(At, 0, 0); PG8_STAGE(PG8_SA(1, 1), a1 + hstep, voffA);
            PG8_WAIT_L(8); PG8_BAR; PG8_WAIT_L(0); PG8_MMA(0, 0, At, B0); PG8_BAR; PG8_SCHED;
            PG8_LDB(B1, 0, 1); PG8_STAGE(PG8_SB(0, 0), b2, voffB);
            PG8_BAR; PG8_WAIT_L(0); PG8_MMA(0, 1, At, B1); PG8_BAR;
            PG8_LDA(At, 0, 1); PG8_STAGE(PG8_SA(0, 0), a2, voffA);
            PG8_BAR; PG8_WAIT_L(0); PG8_MMA(1, 0, At, B0); PG8_BAR; PG8_SCHED;
            PG8_STAGE(PG8_SB(0, 1), b2 + hstep, voffB);
            PG8_WAIT_V(6); PG8_BAR; PG8_MMA(1, 1, At, B1); PG8_BAR;
            PG8_LDB(B0, 1, 0); PG8_SCHED; PG8_LDA(At, 1, 0); PG8_STAGE(PG8_SA(0, 1), a2 + hstep, voffA);
            PG8_WAIT_L(8); PG8_BAR; PG8_WAIT_L(0); PG8_MMA(0, 0, At, B0); PG8_BAR; PG8_SCHED;
            PG8_LDB(B1, 1, 1); PG8_STAGE(PG8_SB(1, 0), b3, voffB);
            PG8_BAR; PG8_WAIT_L(0); PG8_MMA(0, 1, At, B1); PG8_BAR;
            PG8_LDA(At, 1, 1); PG8_STAGE(PG8_SA(1, 0), a3, voffA);
            PG8_BAR; PG8_WAIT_L(0); PG8_MMA(1, 0, At, B0); PG8_BAR; PG8_SCHED;
            PG8_STAGE(PG8_SB(1, 1), b3 + hstep, voffB);
            PG8_WAIT_V(6); PG8_BAR; PG8_MMA(1, 1, At, B1); PG8_BAR;
            }
        }
        }
        if constexpr (ALIGN_EPI) { if (wr == 0) PG8_BAR; }
        if constexpr (!Epi::AFTER_DRAIN) { E(acc, cur, wr, wc, fr, fq); S.done(cur); }
        if (!has_next) break;
#pragma unroll
        for (int a = 0; a < 2; ++a)
#pragma unroll
            for (int b = 0; b < 2; ++b)
#pragma unroll
                for (int m = 0; m < 4; ++m)
#pragma unroll
                    for (int n = 0; n < 2; ++n) acc[a][b][m][n] = (f32x4){0.f, 0.f, 0.f, 0.f};
        cur = nxt; cA = nA; cB = nB; ++ui;
        if constexpr (ALIGN_EPI) { if (wr == 1) PG8_BAR; }
    }
    PG8_WAIT_V(0);
    if constexpr (!ALIGN_EPI) { if (wr == 0) PG8_BAR; }
    PG8_BAR;
    if constexpr (Epi::AFTER_DRAIN) { E.fused(acc, cur, wr, wc, fr, fq, lds, wid, lane); S.done(cur); }
#undef PG8_SA
#undef PG8_SB
#undef PG8_STAGE
#undef PG8_LDA
#undef PG8_LDB
#undef PG8_MMA
#undef PG8_WAIT_V
#undef PG8_WAIT_L
#undef PG8_BAR
#undef PG8_SCHED
}
}
namespace moba {
typedef unsigned short bf16;
typedef short bf16x8 __attribute__((ext_vector_type(8)));
typedef short s16x4 __attribute__((ext_vector_type(4)));
typedef float f32x16 __attribute__((ext_vector_type(16)));
typedef float f32x4 __attribute__((ext_vector_type(4)));
typedef unsigned u32x4 __attribute__((ext_vector_type(4)));
constexpr int D = 128, NW = 8, QBLK = 32, KVBLK = 64, QB = NW * QBLK;
constexpr int SHM_V = KVBLK * D * 2, SHM_K = KVBLK * D * 2;
constexpr int LDS_BYTES = 2 * SHM_V + 2 * SHM_K + NW * 64 * 4;
constexpr float SCALE = 0.08838834764831845f, THR = 8.f;
constexpr int KMH = 2 * 8 * 16 * 128;
#define KSWZ(row, colB) ((row) * 256 + ((colB) ^ (((row) & 7) << 4)))
#define SBAR() __builtin_amdgcn_sched_barrier(0)
__device__ __forceinline__ int v_st(int k, int c) { const int kk = (k & ~0xC) | ((k & 4) << 1) | ((k & 8) >> 1); return ((kk >> 3) * 4 + (c >> 5)) * 512 + ((kk & 7) * 32 + (c & 31)) * 2; }
__device__ __forceinline__ int v_rd_base(int lane) { return ((lane & 3) << 3) | (((lane >> 2) & 3) << 6) | (((lane >> 4) & 1) << 5) | (((lane >> 5) & 1) << 8); }
constexpr int v_rd_off(int d0, int ks, int half) { return d0 * 512 + ks * 4096 + half * 2048; }
__device__ __forceinline__ int crow(int r, int hi) { return (r & 3) + 8 * (r >> 2) + 4 * hi; }
__device__ __forceinline__ unsigned cvtpk(float lo, float hi) { unsigned r; asm volatile("v_cvt_pk_bf16_f32 %0, %1, %2" : "=v"(r) : "v"(lo), "v"(hi)); return r; }
__device__ __forceinline__ bf16x8 pack8(f32x4 a, f32x4 b) { u32x4 w = {cvtpk(a[0], a[1]), cvtpk(a[2], a[3]), cvtpk(b[0], b[1]), cvtpk(b[2], b[3])}; return *reinterpret_cast<bf16x8*>(&w); }
__device__ __forceinline__ bf16x8 load8(const bf16* p) { return *reinterpret_cast<const bf16x8*>(p); }
__device__ __forceinline__ void mask_tile(f32x16& p0, f32x16& p1, int dq) {
    const float NEG = -__builtin_inff();
#pragma unroll
    for (int r = 0; r < 16; ++r) { const int c = (r & 3) + 8 * (r >> 2); if (dq - c < 0) p0[r] = NEG; if (dq - c - 32 < 0) p1[r] = NEG; }
}
__device__ __forceinline__ void mask_all(f32x16& p0, f32x16& p1, bool keep) {
    const float NEG = -__builtin_inff();
#pragma unroll
    for (int r = 0; r < 16; ++r) { p0[r] = keep ? p0[r] : NEG; p1[r] = keep ? p1[r] : NEG; }
}
__device__ __forceinline__ void partialSM(f32x16& p0, f32x16& p1, float& m_reg, float& mn, float& alpha, bool keep) {
    float pmax = p0[0]; for (int r = 1; r < 16; ++r) pmax = fmaxf(pmax, p0[r]); for (int r = 0; r < 16; ++r) pmax = fmaxf(pmax, p1[r]);
    pmax = keep ? pmax : -__builtin_inff();
    { auto rr = __builtin_amdgcn_permlane32_swap(__float_as_uint(pmax), __float_as_uint(pmax), false, false);
      pmax = fmaxf(__uint_as_float(rr[0]), __uint_as_float(rr[1])); }
    constexpr float C2 = 1.4426950408889634f * SCALE;
    if (__builtin_expect(__all((pmax - m_reg) * SCALE <= THR), 1)) { mn = m_reg; alpha = 1.f; }
    else { mn = fmaxf(m_reg, pmax); alpha = __builtin_amdgcn_exp2f((m_reg - mn) * C2); m_reg = mn; }
    const float mnL = keep ? -mn * C2 : -__builtin_inff();
    p0 = p0 * C2 + mnL; p1 = p1 * C2 + mnL;
    for (int r = 0; r < 16; ++r) p0[r] = __builtin_amdgcn_exp2f(p0[r]);
}
__device__ __forceinline__ void finishSM(f32x16& p0, f32x16& p1, float alpha, float& l_reg, bf16x8& pa0, bf16x8& pa1, bf16x8& pa2, bf16x8& pa3) {
    for (int r = 0; r < 16; ++r) p1[r] = __builtin_amdgcn_exp2f(p1[r]);
    float ps;
    { typedef float f32x8_ __attribute__((ext_vector_type(8))); typedef float f32x4_ __attribute__((ext_vector_type(4))); typedef float f32x2_ __attribute__((ext_vector_type(2)));
      const f32x16 s16 = p0 + p1; const f32x8_ s8 = s16.lo + s16.hi; const f32x4_ s4 = s8.lo + s8.hi; const f32x2_ s2 = s4.lo + s4.hi; ps = s2.x + s2.y; }
    { auto rr = __builtin_amdgcn_permlane32_swap(__float_as_uint(ps), __float_as_uint(ps), false, false);
      ps = __uint_as_float(rr[0]) + __uint_as_float(rr[1]); }
    l_reg = l_reg * alpha + ps;
#define PK4(P, B_, OUT) do { unsigned a0 = cvtpk(P[B_+0], P[B_+1]), a1 = cvtpk(P[B_+2], P[B_+3]);                          \
        unsigned b0 = cvtpk(P[B_+4], P[B_+5]), b1 = cvtpk(P[B_+6], P[B_+7]);                                             \
        auto r0 = __builtin_amdgcn_permlane32_swap(a0, b0, false, false); auto r1 = __builtin_amdgcn_permlane32_swap(a1, b1, false, false); \
        u32x4 w = {r0[0], r1[0], r0[1], r1[1]}; OUT = *reinterpret_cast<bf16x8*>(&w); } while (0)
    PK4(p0, 0, pa0); PK4(p0, 8, pa1); PK4(p1, 0, pa2); PK4(p1, 8, pa3);
#undef PK4
}
template <int KB>
__device__ __forceinline__ void qkt(f32x16& p0, f32x16& p1, const char* K_lds, int r32, int hi, const bf16x8* qr) {
    p0 = f32x16{}; p1 = f32x16{};
    const char* kb[4];
#pragma unroll
    for (int dd = 0; dd < 4; ++dd) kb[dd] = K_lds + KB * SHM_K + KSWZ(r32, (dd * 16 + hi * 8) * 2);
#pragma unroll
    for (int d0 = 0; d0 < 8; ++d0) { const char* a = kb[d0 & 3] + (d0 >> 2) * 128;
        bf16x8 b0 = *reinterpret_cast<const bf16x8*>(a);
        bf16x8 b1 = *reinterpret_cast<const bf16x8*>(a + 32 * 256);
        p0 = __builtin_amdgcn_mfma_f32_32x32x16_bf16(b0, qr[d0], p0, 0, 0, 0);
        p1 = __builtin_amdgcn_mfma_f32_32x32x16_bf16(b1, qr[d0], p1, 0, 0, 0); }
}
template <int VB>
__device__ __forceinline__ void pv_tile(f32x16* o, int vb0, bf16x8 pa0, bf16x8 pa1, bf16x8 pa2, bf16x8 pa3) {
#define TRRD(dst, off) asm volatile("ds_read_b64_tr_b16 %0, %1 offset:%2" : "=&v"(dst) : "v"(vb0), "i"(off) : "memory")
#define PV_D0(d0) do { s16x4 l0, l1, l2, l3, h0, h1, h2, h3; constexpr int b_ = VB * SHM_V + v_rd_off(d0, 0, 0); \
        TRRD(l0, b_); TRRD(h0, b_ + 2048); TRRD(l1, b_ + 4096); TRRD(h1, b_ + 6144); TRRD(l2, b_ + 8192); TRRD(h2, b_ + 10240); TRRD(l3, b_ + 12288); TRRD(h3, b_ + 14336); \
        asm volatile("s_waitcnt lgkmcnt(0)" ::: "memory"); SBAR();   \
        o[d0] = __builtin_amdgcn_mfma_f32_32x32x16_bf16(pa0, (bf16x8){l0[0], l0[1], l0[2], l0[3], h0[0], h0[1], h0[2], h0[3]}, o[d0], 0, 0, 0);   \
        o[d0] = __builtin_amdgcn_mfma_f32_32x32x16_bf16(pa1, (bf16x8){l1[0], l1[1], l1[2], l1[3], h1[0], h1[1], h1[2], h1[3]}, o[d0], 0, 0, 0);   \
        o[d0] = __builtin_amdgcn_mfma_f32_32x32x16_bf16(pa2, (bf16x8){l2[0], l2[1], l2[2], l2[3], h2[0], h2[1], h2[2], h2[3]}, o[d0], 0, 0, 0);   \
        o[d0] = __builtin_amdgcn_mfma_f32_32x32x16_bf16(pa3, (bf16x8){l3[0], l3[1], l3[2], l3[3], h3[0], h3[1], h3[2], h3[3]}, o[d0], 0, 0, 0); } while (0)
    PV_D0(0); PV_D0(1); PV_D0(2); PV_D0(3);
#undef PV_D0
#undef TRRD
}
struct BlockRef { const bf16* Q; const bf16* K; const bf16* V; bf16* O; const float* KM; float* ML; int j, tlo, thi; };
struct Seam { bf16x8 qr[8]; bf16x8 st_v0, st_v1, st_k0, st_k1; };
#define ROW(p, k0, rr) ((p) + (size_t)((k0) + (rr)) * PIN + sc)
#define VMW() asm volatile("s_waitcnt vmcnt(0)" ::: "memory")
#define VMWN(n) asm volatile("s_waitcnt vmcnt(%0)" :: "i"(n) : "memory")
#define SLOAD_H(Kp, Vp, k0) do { S.st_v0 = load8(ROW(Vp, k0, sr)); S.st_v1 = load8(ROW(Vp, k0, 32 + sr));              \
                         S.st_k0 = load8(ROW(Kp, k0, sr)); S.st_k1 = load8(ROW(Kp, k0, 32 + sr)); } while (0)
#define SWRITE_HK(bf) do { *(bf16x8*)(K_lds + (bf) * SHM_K + kws) = S.st_k0; *(bf16x8*)(K_lds + (bf) * SHM_K + kws + 32 * 256) = S.st_k1; } while (0)
#define SWRITE_HV(bf) do { *(bf16x8*)(V_lds + (bf) * SHM_V + vst0) = S.st_v0; *(bf16x8*)(V_lds + (bf) * SHM_V + vst1) = S.st_v1; } while (0)
#define SWRITE_H(bf) do { SWRITE_HV(bf); SWRITE_HK(bf); } while (0)
template <int PIN, class Between>
__device__ __forceinline__ void moba_prime(const BlockRef& cur, char* lds, Seam& S, Between&& between) {
    int tid_ = threadIdx.x; asm volatile("" : "+v"(tid_));
    const int tid = tid_, wid = __builtin_amdgcn_readfirstlane(tid >> 6), lane = tid & 63, r32 = lane & 31, hi = lane >> 5;
    const int sr = tid >> 4, sc = (tid & 15) * 8, kws = KSWZ(sr, sc * 2); char* K_lds = lds + 2 * SHM_V;
    for (int d0 = 0; d0 < 8; ++d0) S.qr[d0] = load8(cur.Q + (size_t)(wid * QBLK + r32) * PIN + d0 * 16 + hi * 8);
    SLOAD_H(cur.K, cur.V, cur.tlo * KVBLK); between(); VMW(); SWRITE_HK(0);
    __syncthreads();
}
template <int PIN, int PO>
__device__ __forceinline__ void moba_block(const BlockRef& cur, const BlockRef& nxt, char* lds, Seam& S) {
    int tid_ = threadIdx.x; asm volatile("" : "+v"(tid_));
    const int tid = tid_, wid = __builtin_amdgcn_readfirstlane(tid >> 6), lane = tid & 63, r32 = lane & 31, hi = lane >> 5;
    const int jb = cur.j, P0 = jb * QB;
    const int NT = cur.thi - cur.tlo, TB = cur.tlo;
    const int qlo = P0 + wid * QBLK, qm = qlo + r32 - 4 * hi;
    char* V_lds = lds; char* K_lds = lds + 2 * SHM_V;
    float* ws = (float*)(lds + 2 * SHM_V + 2 * SHM_K) + wid * 64; float* li_l = ws, * al_l = ws + 32;
    float m_reg = -1e30f, l_reg = 0; f32x16 o[4] = {};
    const int sr = tid >> 4, sc = (tid & 15) * 8, vst0 = v_st(sr, sc), vst1 = v_st(32 + sr, sc), kws = KSWZ(sr, sc * 2);
    const int vb0 = (int)(uintptr_t)V_lds + v_rd_base(lane);
    const bf16* Kh = cur.K; const bf16* Vh = cur.V;
    unsigned selmask = 0u;
    if (jb > 0) {
        f32x16 sc16 = f32x16{};
#pragma unroll
        for (int d0 = 0; d0 < 8; ++d0) { bf16x8 a = (bf16x8){0, 0, 0, 0, 0, 0, 0, 0};
            if (r32 < 16) { const float* kp = cur.KM + r32 * D + d0 * 16 + hi * 8; a = pack8(*(const f32x4*)kp, *(const f32x4*)(kp + 4)); }
            sc16 = __builtin_amdgcn_mfma_f32_32x32x16_bf16(a, S.qr[d0], sc16, 0, 0, 0); }
        float s16[16];
#pragma unroll
        for (int r = 0; r < 8; ++r) { auto rr = __builtin_amdgcn_permlane32_swap(__float_as_uint(sc16[r]), __float_as_uint(sc16[r]), false, false);
            s16[(r & 3) + 8 * (r >> 2)] = __uint_as_float(rr[0]); s16[(r & 3) + 8 * (r >> 2) + 4] = __uint_as_float(rr[1]); }
        const float NEGI = -__builtin_inff();
#pragma unroll
        for (int n = 0; n < 16; ++n) s16[n] = (n < jb) ? s16[n] : NEGI;
#pragma unroll
        for (int it = 0; it < 3; ++it) { float best = NEGI; int bi = 16;
#pragma unroll
            for (int n = 0; n < 16; ++n) { if (s16[n] > best) { best = s16[n]; bi = n; } }
            selmask |= (bi < 16) ? (1u << bi) : 0u;
#pragma unroll
            for (int n = 0; n < 16; ++n) s16[n] = (n == bi) ? NEGI : s16[n]; }
    }
#define RESC(a) do { if (__any((a) < 1.f)) { if (hi == 0) al_l[r32] = (a); asm volatile("s_waitcnt lgkmcnt(0)" ::: "memory");              \
                     for (int d_ = 0; d_ < 4; ++d_) for (int r = 0; r < 16; ++r) o[d_][r] *= al_l[crow(r, hi)]; } } while (0)
#define KBASE(t) ((TB + (t)) * KVBLK)
#define MASKT(P0_, P1_, t) do { const int kb_ = KBASE(t); const int nb_ = (TB + (t)) >> 2; keep_ = true; \
        if (nb_ < jb) { keep_ = ((selmask >> nb_) & 1u) != 0u; } \
        else if (kb_ + KVBLK - 1 > qlo) { mask_tile(P0_, P1_, qm - kb_); } } while (0)
    constexpr int NQL = 8;
#define SEAM_K0() do { VMWN(NQL); SWRITE_HK(0); SBAR(); } while (0)
    f32x16 pA0, pA1, pB0, pB1; float mnA, mnB, alA, alB; bf16x8 pa0, pa1, pa2, pa3; bool keep_ = true;
    SWRITE_HV(0); SBAR();
    if (NT > 1) { SLOAD_H(Kh, Vh, KBASE(1)); }
    SBAR(); qkt<0>(pA0, pA1, K_lds, r32, hi, S.qr);
    MASKT(pA0, pA1, 0); partialSM(pA0, pA1, m_reg, mnA, alA, keep_);
    if (NT > 1) { VMW(); SWRITE_H(1); }
    __syncthreads();
#define HALF_STEP(PX0, PX1, mnX, alX, PY0, PY1, alY, t, KB, VB, SB) do {                                                      \
        SBAR(); qkt<KB>(PX0, PX1, K_lds, r32, hi, S.qr);                                             \
        finishSM(PY0, PY1, alY, l_reg, pa0, pa1, pa2, pa3); SBAR();                                                           \
        if ((t) + 1 < NT) { SLOAD_H(Kh, Vh, KBASE((t) + 1)); SBAR(); }                                               \
        pv_tile<VB>(o, vb0, pa0, pa1, pa2, pa3); MASKX(PX0, PX1, (t)); partialSM(PX0, PX1, m_reg, mnX, alX, keep_);                                        \
        __syncthreads();                                                                                                      \
        if ((t) + 1 < NT) { VMW(); SWRITE_H(SB); }                                                                          \
        RESC(alX); __syncthreads(); } while (0)
    const int tpast = 4 * jb - TB;
    int t = 1;
#define MASKX(P0_, P1_, t_) do { keep_ = ((selmask >> ((TB + (t_)) >> 2)) & 1u) != 0u; } while (0)
    for (; t + 1 < NT && t + 1 < tpast; t += 2) {
        HALF_STEP(pB0, pB1, mnB, alB, pA0, pA1, alA, t, 1, 0, 0);
        HALF_STEP(pA0, pA1, mnA, alA, pB0, pB1, alB, t + 1, 0, 1, 1);
    }
#undef MASKX
#define MASKX(P0_, P1_, t_) MASKT(P0_, P1_, t_)
    for (; t + 1 < NT; t += 2) {
        HALF_STEP(pB0, pB1, mnB, alB, pA0, pA1, alA, t, 1, 0, 0);
        HALF_STEP(pA0, pA1, mnA, alA, pB0, pB1, alB, t + 1, 0, 1, 1);
    }
#undef MASKX
    const bool even = (NT & 1) == 0;
    if (even) { SBAR(); qkt<1>(pB0, pB1, K_lds, r32, hi, S.qr); SBAR(); }
    SLOAD_H(nxt.K, nxt.V, nxt.tlo * KVBLK); SBAR();
#pragma unroll
    for (int d0 = 0; d0 < 8; ++d0) S.qr[d0] = load8(nxt.Q + (size_t)(wid * QBLK + r32) * PIN + d0 * 16 + hi * 8);
    SBAR();
    finishSM(pA0, pA1, alA, l_reg, pa0, pa1, pa2, pa3); SBAR();
    pv_tile<0>(o, vb0, pa0, pa1, pa2, pa3);
    if (even) { MASKT(pB0, pB1, NT - 1); partialSM(pB0, pB1, m_reg, mnB, alB, keep_); __syncthreads(); RESC(alB);
        finishSM(pB0, pB1, alB, l_reg, pa0, pa1, pa2, pa3); SBAR(); pv_tile<1>(o, vb0, pa0, pa1, pa2, pa3); }
    SBAR(); SEAM_K0();
    if (hi == 0) li_l[r32] = l_reg; asm volatile("s_waitcnt lgkmcnt(0)" ::: "memory");
    float rli[16];
#pragma unroll
    for (int r = 0; r < 16; ++r) { const float lv = li_l[crow(r, hi)]; rli[r] = lv > 0.f ? __builtin_amdgcn_rcpf(lv) : 0.f; }
    if (hi == 0) { typedef float f32x2 __attribute__((ext_vector_type(2))); *(f32x2*)(cur.ML + (size_t)(wid * QBLK + r32) * 16) = (f32x2){m_reg, l_reg}; }
    bf16* Ow = cur.O + (size_t)(wid * QBLK) * PO;
#pragma unroll
    for (int r = 0; r < 16; ++r) { const int orow = crow(r, hi);
#pragma unroll
        for (int d0 = 0; d0 < 4; ++d0) { const float v = o[d0][r] * rli[r];
            const float vn = __shfl_xor(v, 1);
            if ((r32 & 1) == 0) *(unsigned*)(Ow + (size_t)orow * PO + d0 * 32 + r32) = cvtpk(v, vn); } }
    __syncthreads();
#undef RESC
#undef KBASE
#undef MASKT
#undef SEAM_K0
#undef HALF_STEP
}
#undef ROW
#undef VMW
#undef VMWN
#undef SLOAD_H
#undef SWRITE_HK
#undef SWRITE_HV
#undef SWRITE_H
#undef KSWZ
#undef SBAR
}

constexpr int NWAVES = 8, NTHR = 512; constexpr float RMS_EPS = 1e-6f;
constexpr int BATCH = 2, SEQ = 4096, T = BATCH * SEQ, DM = 2048, DEPTH = 4, PLE = 256;
constexpr int CCH = 512, CWID = 31;
constexpr int GH = 4, GDK = 64, GDV = 128, GRANK = 16, GCH = 64, GNC = SEQ / GCH;
constexpr int MH = 8, MHD = 128, MBLK = 256, MNB = SEQ / MBLK;
constexpr int FF = 5632, FF2 = 2 * FF, IN_COLS = 5648, NGATE = 3 * DM;
constexpr int ZN = 47 * 256;
constexpr int ZC_GLU = 0, ZC_GQ = 1024, ZC_GK = 1280, ZC_GV = 1536, ZC_GR = 2048, ZC_MQ = 2560, ZC_MK = 3584, ZC_MV = 4608, ZC_GATE = 5632, ZC_GA = 11776;
constexpr size_t MiB = 1u << 20;
constexpr size_t WS_CTL = 0, CTL_ZERO_BYTES = 32 * 1024;
constexpr int CW_TMO = 0, CW_BAR = 4096;
constexpr size_t WS_ROWSS = 1 * MiB;
constexpr size_t WS_W = 4 * MiB;
constexpr size_t WO_W1 = 0, WO_CA = WO_W1 + (size_t)ZN * DM * 2, WO_GL = WO_CA + (size_t)DM * CCH * 2, WO_MO = WO_GL + (size_t)DM * 512 * 2, WO_OU = WO_MO + (size_t)DM * 1024 * 2,
                 WO_UP = WO_OU + (size_t)DM * DM * 2, WO_DN = WO_UP + (size_t)FF2 * DM * 2, WO_PG = WO_DN + (size_t)DM * FF * 2, WO_PL = WO_PG + (size_t)DM * DM * 2, W_LAYER = WO_PL + (size_t)DM * PLE * 2;
static_assert(W_LAYER == 138 * MiB, "weight bytes per layer");
constexpr size_t WS_ACT = WS_W + DEPTH * W_LAYER;
constexpr size_t WS_XBA = WS_ACT, WS_XBB = WS_XBA + 32 * MiB, WS_XBC = WS_XBB + 32 * MiB, WS_ZB = WS_XBC + 32 * MiB;
constexpr size_t WS_TMP = WS_ZB + 188 * MiB, WS_MRG = WS_TMP + 64 * MiB;
constexpr size_t WS_ACONV = WS_MRG + 32 * MiB, WS_OMOBA = WS_ACONV + 8 * MiB, WS_GQT = WS_OMOBA + 16 * MiB, WS_GINTRA = WS_GQT + 4 * MiB, WS_GDELTA = WS_GINTRA + 16 * MiB,
                 WS_GST = WS_GDELTA + 16 * MiB, WS_GDEC = WS_GST + 8 * MiB, WS_OGLA = WS_GDEC + 1 * MiB, WS_GA = WS_OGLA + 8 * MiB, WS_KMEAN = WS_GA + 1 * MiB, WS_PB = WS_KMEAN + 1 * MiB,
                 WS_PE = WS_PB + 16 * MiB, WS_RSP = WS_PE + 32 * MiB, WS_OP1 = WS_RSP + 13 * MiB, WS_ML = WS_OP1 + 16 * MiB, WS_EDGE = WS_ML + 2 * MiB, WS_AGLU = WS_EDGE + 24 * MiB, WS_QKV = WS_AGLU + 8 * MiB, WS_ACAT = WS_QKV + 48 * MiB, WS_G8 = WS_ACAT + 32 * MiB, WS_END = WS_G8 + 48 * MiB;
static_assert((size_t)T * ZN * 2 <= 188 * MiB && (size_t)T * FF2 * 2 <= 188 * MiB && (size_t)T * FF * 2 <= 96 * MiB, "overlays");
constexpr int RING_OFF = 0, RING_BYTES = 131072, LDSCTL_OFF = RING_BYTES, MISC_OFF = LDSCTL_OFF + 320, XL_OFF = LDSCTL_OFF + 2048  , RT_OFF = LDSCTL_OFF + 10240  , SLOT_OFF = LDSCTL_OFF + 1280  , LDS_BYTES = 147456;

#define GAS __attribute__((address_space(1)))
#define LAS __attribute__((address_space(3)))
typedef unsigned short bf16;
typedef unsigned v4u __attribute__((ext_vector_type(4)));
typedef float f32x4 __attribute__((ext_vector_type(4)));
typedef short bf16x8 __attribute__((ext_vector_type(8)));
typedef GAS unsigned gu32;
#define RLX_AGENT __ATOMIC_RELAXED, __HIP_MEMORY_SCOPE_AGENT
#define LDS_WAIT() asm volatile("s_waitcnt lgkmcnt(0)" ::: "memory")
#define VM_WAIT() asm volatile("s_waitcnt vmcnt(0)" ::: "memory")
__device__ __forceinline__ unsigned f2bf(float f) { unsigned u = __builtin_bit_cast(unsigned, f); return (u + 0x7fffu + ((u >> 16) & 1u)) >> 16; }
__device__ __forceinline__ unsigned pk2(float lo, float hi) { return f2bf(lo) | (f2bf(hi) << 16); }
__device__ __forceinline__ float bflo(unsigned w) { return __uint_as_float(w << 16); }
__device__ __forceinline__ float bfhi(unsigned w) { return __uint_as_float(w & 0xffff0000u); }
__device__ __forceinline__ float sigm(float v) { return __builtin_amdgcn_rcpf(1.0f + __builtin_amdgcn_exp2f(-1.4426950408889634f * v)); }
__device__ __forceinline__ float wave_sum(float v) {
#pragma unroll
    for (int o = 1; o < 64; o <<= 1) v += __shfl_xor(v, o);
    return v;
}
__device__ __forceinline__ void unpack8(const v4u w, float (&f)[8]) { f[0] = bflo(w.x); f[1] = bfhi(w.x); f[2] = bflo(w.y); f[3] = bfhi(w.y); f[4] = bflo(w.z); f[5] = bfhi(w.z); f[6] = bflo(w.w); f[7] = bfhi(w.w); }
__device__ __forceinline__ v4u pack8f(const float (&f)[8]) { v4u w; w.x = pk2(f[0], f[1]); w.y = pk2(f[2], f[3]); w.z = pk2(f[4], f[5]); w.w = pk2(f[6], f[7]); return w; }

#define XB_TMO      128
#define XB_XCNT(j)  (256  + 64 * (j))
#define XB_XSUB(j)  (1280 + 64 * (j))
#define XB_XGEN(j)  (2304 + 64 * (j))
#define XB_TOP      3328
#define XB_TOPGEN   3392
#define XCD_BAR_WORDS 3456
#define XB_SPIN_CAP (1u << 18)

__device__ __forceinline__ unsigned xb_ld(unsigned* p)              { return __hip_atomic_load(p, __ATOMIC_RELAXED, __HIP_MEMORY_SCOPE_AGENT); }
__device__ __forceinline__ unsigned xb_add(unsigned* p, unsigned v) { return __hip_atomic_fetch_add(p, v, __ATOMIC_RELAXED, __HIP_MEMORY_SCOPE_AGENT); }
__device__ __forceinline__ unsigned xb_xcc_id() { return (unsigned)__builtin_amdgcn_s_getreg((3 << 11) | 20) & 0xFu; }
#define XB_SPIN(cond, bar) do { unsigned _sp = 0; while (cond) { __builtin_amdgcn_s_sleep(1); \
    if ((++_sp & 255u) == 0u) { if (xb_ld(&(bar)[XB_TMO])) break; if (_sp > XB_SPIN_CAP) { atomicAdd(&(bar)[XB_TMO], 1u); break; } } } } while (0)

struct XcdBarrier {
    unsigned* bar; unsigned x;
    volatile LAS unsigned* st;
};

__device__ __forceinline__ XcdBarrier xcd_barrier_post(unsigned* bar, volatile LAS unsigned* st) {
    XcdBarrier b; b.bar = bar; b.x = xb_xcc_id(); b.st = st;
    if (threadIdx.x == 0) (void)xb_add(&bar[XB_XCNT(b.x)], 1u);
    return b;
}
__device__ __forceinline__ void xcd_barrier_complete(unsigned* bar, unsigned x, unsigned& nloc, unsigned& nx) {
    const unsigned G = gridDim.x * gridDim.y * gridDim.z;
    unsigned sum, cnt, mine, sp = 0u;
    for (;;) {
        sum = 0u; cnt = 0u; mine = 0u;
#pragma unroll
        for (unsigned j = 0; j < 16; ++j) { const unsigned c = xb_ld(&bar[XB_XCNT(j)]); sum += c; cnt += (c > 0u) ? 1u : 0u; mine = (j == x) ? c : mine; }
        if (sum == G) break;
        __builtin_amdgcn_s_sleep(1);
        if ((++sp & 255u) == 0u) { if (xb_ld(&bar[XB_TMO])) break; if (sp > XB_SPIN_CAP) { atomicAdd(&bar[XB_TMO], 1u); break; } }
    }
    nloc = mine > 0u ? mine : 1u; nx = cnt > 0u ? cnt : 1u;
}

__device__ __forceinline__ void xcd_barrier(const XcdBarrier& b) {
    asm volatile("s_waitcnt vmcnt(0)" ::: "memory");
    __syncthreads();
    if (threadIdx.x == 0) {
        unsigned* bar = b.bar;
        __builtin_amdgcn_s_waitcnt(0);
        unsigned nloc = b.st[0], nx = b.st[1];
        if (nloc == 0u) { xcd_barrier_complete(bar, b.x, nloc, nx); b.st[0] = nloc; b.st[1] = nx; }
        const unsigned old = xb_add(&bar[XB_XSUB(b.x)], 1u);
        const unsigned gen = old / nloc;
        if (old + 1u == (gen + 1u) * nloc) {
            __builtin_amdgcn_fence(__ATOMIC_RELEASE, "agent");
            asm volatile("s_waitcnt vmcnt(0)" ::: "memory");
            const unsigned og = xb_add(&bar[XB_TOP], 1u);
            const unsigned tg = og / nx;
            if (og + 1u == (tg + 1u) * nx) xb_add(&bar[XB_TOPGEN], 1u);
            else XB_SPIN(xb_ld(&bar[XB_TOPGEN]) == tg, bar);
            __builtin_amdgcn_fence(__ATOMIC_ACQUIRE, "agent");
            xb_add(&bar[XB_XGEN(b.x)], 1u);
            asm volatile("s_waitcnt vmcnt(0)" ::: "memory");
        } else {
            XB_SPIN(xb_ld(&bar[XB_XGEN(b.x)]) == gen, bar);
            __builtin_amdgcn_fence(__ATOMIC_ACQUIRE, "agent");
            asm volatile("s_waitcnt vmcnt(0)" ::: "memory");
        }
    }
    __syncthreads();
}
enum { MAP_ID = 0, MAP_IN = 1, MAP_UP = 2 };
template <int MAP> __device__ __forceinline__ int map_col(int n, int off) {
    if (MAP == MAP_ID) return n + off;
    if (MAP == MAP_UP) { const int isv = n >= FF ? 1 : 0, c = n - isv * FF; return 256 * (c >> 7) + 128 * isv + (c & 127); }
    if (n < 512) return 256 * (n >> 7) + (n & 127);
    if (n < 1024) { const int c = n - 512; return 256 * (c >> 7) + 128 + (c & 127); }
    if (n < 2560) return n;
    if (n < 2576) return ZC_GA + (n - 2560);
    return n - 16;
}
template <int MAP> __device__ __forceinline__ void tr_item(const float* W, int K, int N, const float* gain, bf16* WT, int off, LAS float* scr, int item, int lane) {
    const int nblk = (N + 31) >> 5, kb = item / nblk, nb = item - kb * nblk, k0 = 64 * kb, n0 = 32 * nb;
    const int nl = n0 + (lane & 31); const bool ok = nl < N;
#pragma unroll 8
    for (int i = 0; i < 32; ++i) { const int kk = 2 * i + (lane >> 5); float v = ok ? W[(size_t)(k0 + kk) * N + nl] : 0.f; if (gain) v *= gain[k0 + kk]; scr[kk * 33 + (lane & 31)] = v; }
    LDS_WAIT(); asm volatile("" ::: "memory");
    const int c = lane & 7;
#pragma unroll
    for (int j = 0; j < 4; ++j) { const int n = (lane >> 3) + 8 * j; const LAS float* s = scr + (8 * c) * 33 + n;
        v4u o; o.x = pk2(s[0 * 33], s[1 * 33]); o.y = pk2(s[2 * 33], s[3 * 33]); o.z = pk2(s[4 * 33], s[5 * 33]); o.w = pk2(s[6 * 33], s[7 * 33]);
        if (n0 + n < N) *(GAS v4u*)(WT + (size_t)map_col<MAP>(n0 + n, off) * K + k0 + 8 * c) = o; }
    LDS_WAIT(); asm volatile("" ::: "memory");
}

template <int MAP> __device__ __forceinline__ void tr2_item(const float* W, int K, int N, const float* gain, bf16* WT, int off, int item, int lane) {
    const int ngrp = (N + 63) >> 6, kb = item / ngrp, nb = item - kb * ngrp, k0 = 64 * kb, n = 64 * nb + lane;
    if (n >= N) return;
    const float* src = W + (size_t)k0 * N + n;
    float v[64];
#pragma unroll
    for (int r = 0; r < 64; ++r) v[r] = __builtin_nontemporal_load((const GAS float*)(src + (size_t)r * N));
    if (gain) {
#pragma unroll
        for (int r = 0; r < 64; ++r) v[r] *= gain[k0 + r]; }
    bf16* dst = WT + (size_t)map_col<MAP>(n, off) * K + k0;
#pragma unroll
    for (int kg = 0; kg < 8; ++kg) { v4u o; o.x = pk2(v[8 * kg], v[8 * kg + 1]); o.y = pk2(v[8 * kg + 2], v[8 * kg + 3]); o.z = pk2(v[8 * kg + 4], v[8 * kg + 5]); o.w = pk2(v[8 * kg + 6], v[8 * kg + 7]);
        *(GAS v4u*)(dst + kg * 8) = o; }
}

__device__ __forceinline__ int map_col_rt(int map, int n, int off) {
    if (map == MAP_ID) return n + off;
    if (map == MAP_UP) return map_col<MAP_UP>(n, 0);
    return map_col<MAP_IN>(n, 0);
}
constexpr int CT_IN = 32 * 44, CT_GT = 32 * 48, CT_CA = 8 * 16, CT_GL = 8 * 16, CT_MO = 16 * 16, CT_OU = 32 * 16, CT_UP = 32 * 88, CT_DN = 88 * 16, CT_PG = 32 * 16, CT_PL = 4 * 16;
constexpr int CT_LAYER = CT_IN + CT_GT + CT_CA + CT_GL + CT_MO + CT_OU + CT_UP + CT_DN + CT_PG + CT_PL;
struct CvTile { const float* W; const float* gain; bf16* WT; int K, N, map, off, k0, n0, ldk; };
__device__ __forceinline__ void conv_branch_item(int item, const bf16* zb, const float* cw, const float* cb, const float* lg, const float* lb, bf16* aconv, LAS float* XA, int tid) {
    const int m0 = item * 32, t0 = m0 & (SEQ - 1), lane = tid & 63, wave = tid >> 6;
    { v4u ld[8];
#pragma unroll
      for (int pass = 0; pass < 8; ++pass) { const int r = pass * 8 + wave, c0 = lane * 8; ld[pass] = (v4u){0u, 0u, 0u, 0u};
          if (r < 62 && t0 - 30 + r >= 0) ld[pass] = *(const GAS v4u*)(zb + (size_t)(m0 - 30 + r) * CCH + c0); }
#pragma unroll
      for (int pass = 0; pass < 8; ++pass) { const int r = pass * 8 + wave, c0 = lane * 8;
          if (r < 62) { float a[8]; unpack8(ld[pass], a);
              *(LAS f32x4*)(XA + r * 512 + c0) = (f32x4){a[0], a[1], a[2], a[3]}; *(LAS f32x4*)(XA + r * 512 + c0 + 4) = (f32x4){a[4], a[5], a[6], a[7]}; } } }
    __syncthreads();
    float w[CWID];
#pragma unroll
    for (int j = 0; j < CWID; ++j) w[j] = cw[j * CCH + tid];
    const float bias = cb[tid];
    float yv[32];
#pragma unroll
    for (int rb = 0; rb < 4; ++rb) { float x[38];
#pragma unroll
        for (int i = 0; i < 38; ++i) x[i] = XA[(rb * 8 + i) * 512 + tid];
#pragma unroll
        for (int r = 0; r < 8; ++r) { float y = bias;
#pragma unroll
            for (int j = 0; j < CWID; ++j) y = fmaf(w[j], x[r + j], y);
            yv[rb * 8 + r] = y; } }
    __syncthreads();
#pragma unroll
    for (int r = 0; r < 32; ++r) XA[r * 512 + tid] = yv[r];
    __syncthreads();
    const f32x4 g0 = *(const f32x4*)(lg + lane * 8), g1 = *(const f32x4*)(lg + lane * 8 + 4), b0 = *(const f32x4*)(lb + lane * 8), b1 = *(const f32x4*)(lb + lane * 8 + 4);
#pragma unroll 1
    for (int q = 0; q < 4; ++q) { const int r = wave * 4 + q, c0 = lane * 8;
        const f32x4 a0 = *(const LAS f32x4*)(XA + r * 512 + c0), a1 = *(const LAS f32x4*)(XA + r * 512 + c0 + 4);
        float v[8] = {a0[0], a0[1], a0[2], a0[3], a1[0], a1[1], a1[2], a1[3]};
        float s = 0.f;
#pragma unroll
        for (int i = 0; i < 8; ++i) s += v[i];
        const float mean = wave_sum(s) * (1.f / CCH); float q2 = 0.f;
#pragma unroll
        for (int i = 0; i < 8; ++i) { v[i] -= mean; q2 += v[i] * v[i]; }
        const float rstd = __builtin_amdgcn_rsqf(wave_sum(q2) * (1.f / CCH) + RMS_EPS);
        const float gg[8] = {g0[0], g0[1], g0[2], g0[3], g1[0], g1[1], g1[2], g1[3]}, bb[8] = {b0[0], b0[1], b0[2], b0[3], b1[0], b1[1], b1[2], b1[3]};
        float o[8];
#pragma unroll
        for (int i = 0; i < 8; ++i) { const float y = v[i] * rstd * gg[i] + bb[i]; o[i] = y * sigm(y); }
        *(GAS v4u*)(aconv + (size_t)(m0 + r) * 2048 + c0) = pack8f(o); }
    __syncthreads();
}

__device__ __forceinline__ void kmean_item(int item, const bf16* zb, float* kmean, LAS float* CS, int tid) {
    const int b = item >> 7, n = (item >> 3) & 15, h = item & 7, lane = tid & 63, wave = tid >> 6;
    const int m0 = ((BATCH + b) * MH + h) * SEQ + n * MBLK, c0 = (lane & 15) * 8;
    float cs[8] = {0.f, 0.f, 0.f, 0.f, 0.f, 0.f, 0.f, 0.f};
#pragma unroll
    for (int p = 0; p < 8; ++p) { const int row = m0 + wave * 32 + p * 4 + (lane >> 4); float v[8]; unpack8(*(const GAS v4u*)(zb + (size_t)row * MHD + c0), v);
#pragma unroll
        for (int i = 0; i < 8; ++i) cs[i] += v[i]; }
#pragma unroll
    for (int i = 0; i < 8; ++i) { cs[i] += __shfl_xor(cs[i], 16); cs[i] += __shfl_xor(cs[i], 32); }
    if (lane < 16) {
#pragma unroll
        for (int i = 0; i < 8; ++i) CS[wave * 128 + c0 + i] = cs[i]; }
    __syncthreads();
    if (tid < 128) { float s = 0.f;
#pragma unroll
        for (int w = 0; w < 8; ++w) s += CS[w * 128 + tid];
        kmean[((size_t)(b * MH + h) * MNB + n) * MHD + tid] = s * (1.f / MBLK); }
    __syncthreads();
}

__device__ __forceinline__ void moba_combine(size_t i, const bf16* o0, const bf16* o1, const float* ml, bf16* out) {
    const size_t row = i >> 7; const int h = (int)(i >> 4) & 7;
    typedef float f32x2v __attribute__((ext_vector_type(2)));
    const f32x2v a = *(const f32x2v*)(ml + (row * 8 + h) * 2), b = *(const f32x2v*)(ml + ((size_t)T * 8 + row * 8 + h) * 2);
    constexpr float C2 = 1.4426950408889634f * 0.08838834764831845f;
    const float m = fmaxf(a.x, b.x), w0 = a.y * __builtin_amdgcn_exp2f((a.x - m) * C2), w1 = b.y * __builtin_amdgcn_exp2f((b.x - m) * C2), inv = __builtin_amdgcn_rcpf(w0 + w1);
    float x[8], y[8]; unpack8(*((const GAS v4u*)o0 + i), x); unpack8(*((const GAS v4u*)o1 + i), y);
#pragma unroll
    for (int q = 0; q < 8; ++q) x[q] = (w0 * x[q] + w1 * y[q]) * inv;
    *(GAS v4u*)(out + row * 2048 + (i & 127) * 8) = pack8f(x);
}
constexpr int GL_LA = 0, GL_W2 = 16640, GL_BA = 20736, GL_QT = 21504, GL_KT = 30720, GL_KD = 39936, GL_VT = 49152, GL_PP = 67584, GL_END = 76800, GLS = 72;
struct GlaLocRegs { f32x4 gav[4]; v4u qraw, kraw, v0raw, v1raw; };
__device__ __forceinline__ void gla_local_load(int item, const bf16* zb, const float* ga, GlaLocRegs& R, int tid) {
    const int bh = item >> 6, c = item & 63, b = bh >> 2, h = bh & 3, m0 = b * SEQ + c * GCH, t = tid >> 3, d0 = (tid & 7) * 8, e0 = (tid & 7) * 16;
#pragma unroll
    for (int q = 0; q < 4; ++q) R.gav[q] = *(const GAS f32x4*)(ga + (size_t)(m0 + t) * GRANK + 4 * q);
    R.qraw = *(const GAS v4u*)(zb + (size_t)(m0 + t) * ZN + ZC_GQ + h * GDK + d0); R.kraw = *(const GAS v4u*)(zb + (size_t)(m0 + t) * ZN + ZC_GK + h * GDK + d0);
    const bf16* vp = zb + (size_t)(m0 + t) * ZN + ZC_GV + h * GDV + e0; R.v0raw = *(const GAS v4u*)vp; R.v1raw = *(const GAS v4u*)(vp + 8);
}
__device__ __forceinline__ void gla_local_compute(int item, const GlaLocRegs& R, const float* wa2, const float* ba, bf16* gqt, float* gintra, float* gdelta, float* gdec, LAS unsigned char* L, int tid) {
    const int bh = item >> 6, c = item & 63, b = bh >> 2, h = bh & 3, m0 = b * SEQ + c * GCH, lane = tid & 63, wave = tid >> 6, l15 = lane & 15, quad = lane >> 4;
    LAS float* LA = (LAS float*)(L + GL_LA); LAS float* W2 = (LAS float*)(L + GL_W2); LAS float* BA = (LAS float*)(L + GL_BA);
    LAS bf16* QT = (LAS bf16*)(L + GL_QT); LAS bf16* KT = (LAS bf16*)(L + GL_KT); LAS bf16* KD = (LAS bf16*)(L + GL_KD); LAS bf16* VT = (LAS bf16*)(L + GL_VT); LAS bf16* PP = (LAS bf16*)(L + GL_PP);
    const int t = tid >> 3, d0 = (tid & 7) * 8;
    const f32x4 (&gav)[4] = R.gav; const v4u qraw = R.qraw, kraw = R.kraw;
    for (int e = tid; e < GRANK * GDK; e += NTHR) W2[e] = wa2[(e >> 6) * (GH * GDK) + h * GDK + (e & 63)];
    if (tid < GDK) BA[tid] = ba[h * GDK + tid];
    { const int e0 = (tid & 7) * 16;
        float v0[8], v1[8]; unpack8(R.v0raw, v0); unpack8(R.v1raw, v1);
#pragma unroll
        for (int i = 0; i < 8; ++i) { VT[(e0 + i) * GLS + t] = (bf16)f2bf(v0[i]); VT[(e0 + 8 + i) * GLS + t] = (bf16)f2bf(v1[i]); } }
    __syncthreads();
    { float g[GRANK];
#pragma unroll
        for (int q = 0; q < 4; ++q) { const f32x4 x = gav[q]; g[4 * q] = x[0]; g[4 * q + 1] = x[1]; g[4 * q + 2] = x[2]; g[4 * q + 3] = x[3]; }
#pragma unroll
        for (int i = 0; i < 8; ++i) { float x = BA[d0 + i];
#pragma unroll
            for (int r = 0; r < GRANK; ++r) x = fmaf(g[r], W2[r * GDK + d0 + i], x);
            const float ls = fminf(x, 0.f) - __logf(1.0f + __expf(-fabsf(x)));
            LA[t * 65 + d0 + i] = ls * (1.0f / 16.0f); } }
    __syncthreads();
    if (tid < GDK) { float s = 0.f;
#pragma unroll 8
        for (int tt = 0; tt < GCH; ++tt) { s += LA[tt * 65 + tid]; LA[tt * 65 + tid] = s; } }
    __syncthreads();
    { float q[8], k[8]; unpack8(qraw, q); unpack8(kraw, k);
        float qt[8], kt[8];
#pragma unroll
        for (int i = 0; i < 8; ++i) { const float bc = LA[t * 65 + d0 + i], bl = LA[63 * 65 + d0 + i];
            qt[i] = q[i] * 0.125f * __expf(bc); kt[i] = k[i] * __expf(-bc); KD[(d0 + i) * GLS + t] = (bf16)f2bf(k[i] * __expf(bl - bc));
            if (t == GCH - 1) gdec[(size_t)item * GDK + d0 + i] = __expf(bl); }
        const v4u qw = pack8f(qt), kw = pack8f(kt);
        *(LAS v4u*)(QT + t * GLS + d0) = qw; *(LAS v4u*)(KT + t * GLS + d0) = kw;
        *(GAS v4u*)(gqt + (size_t)(m0 + t) * (GH * GDK) + h * GDK + d0) = qw; }
    __syncthreads();
#pragma unroll
    for (int i = 0; i < 2; ++i) { const int tile = wave * 2 + i, tr = tile >> 2, tc = tile & 3; f32x4 acc = {0.f, 0.f, 0.f, 0.f};
#pragma unroll
        for (int k0 = 0; k0 < 64; k0 += 32) { const bf16x8 a = *(const LAS bf16x8*)(QT + (tr * 16 + l15) * GLS + k0 + quad * 8), bb = *(const LAS bf16x8*)(KT + (tc * 16 + l15) * GLS + k0 + quad * 8);
            acc = __builtin_amdgcn_mfma_f32_16x16x32_bf16(a, bb, acc, 0, 0, 0); }
#pragma unroll
        for (int r = 0; r < 4; ++r) { const int tt = tr * 16 + quad * 4 + r, ss = tc * 16 + l15; PP[tt * GLS + ss] = (bf16)f2bf(ss <= tt ? acc[r] : 0.f); } }
    __syncthreads();
#pragma unroll
    for (int i = 0; i < 4; ++i) { const int tile = wave * 4 + i, tr = tile >> 3, te = tile & 7; f32x4 acc = {0.f, 0.f, 0.f, 0.f};
#pragma unroll
        for (int k0 = 0; k0 < 64; k0 += 32) { const bf16x8 a = *(const LAS bf16x8*)(PP + (tr * 16 + l15) * GLS + k0 + quad * 8), bb = *(const LAS bf16x8*)(VT + (te * 16 + l15) * GLS + k0 + quad * 8);
            acc = __builtin_amdgcn_mfma_f32_16x16x32_bf16(a, bb, acc, 0, 0, 0); }
#pragma unroll
        for (int r = 0; r < 4; ++r) gintra[(size_t)(m0 + tr * 16 + quad * 4 + r) * (GH * GDV) + h * GDV + te * 16 + l15] = acc[r]; }
#pragma unroll
    for (int i = 0; i < 4; ++i) { const int tile = wave * 4 + i, te = tile >> 2, td = tile & 3; f32x4 acc = {0.f, 0.f, 0.f, 0.f};
#pragma unroll
        for (int k0 = 0; k0 < 64; k0 += 32) { const bf16x8 a = *(const LAS bf16x8*)(VT + (te * 16 + l15) * GLS + k0 + quad * 8), bb = *(const LAS bf16x8*)(KD + (td * 16 + l15) * GLS + k0 + quad * 8);
            acc = __builtin_amdgcn_mfma_f32_16x16x32_bf16(a, bb, acc, 0, 0, 0); }
#pragma unroll
        for (int r = 0; r < 4; ++r) gdelta[(size_t)item * (GDK * GDV) + (te * 16 + quad * 4 + r) * GDK + td * 16 + l15] = acc[r]; }
    __syncthreads();
}
__device__ __forceinline__ void gla_local_item(int item, const bf16* zb, const float* ga, const float* wa2, const float* ba, bf16* gqt, float* gintra, float* gdelta, float* gdec, LAS unsigned char* L, int tid) {
    GlaLocRegs R; gla_local_load(item, zb, ga, R, tid); gla_local_compute(item, R, wa2, ba, gqt, gintra, gdelta, gdec, L, tid); }
__device__ __forceinline__ void gla_scan(int gid, const float* gdelta, const float* gdec, bf16* gst) {
    const int bh = gid >> 13, idx = gid & 8191, d = idx & 63;
    float dl[GNC], dc[GNC];
#pragma unroll
    for (int c = 0; c < GNC; ++c) { const size_t it = (size_t)bh * GNC + c; dl[c] = gdelta[it * 8192 + idx]; dc[c] = gdec[it * GDK + d]; }
    float S = 0.f;
#pragma unroll
    for (int c = 0; c < GNC; ++c) { gst[((size_t)bh * GNC + c) * 8192 + idx] = (bf16)f2bf(S); S = fmaf(S, dc[c], dl[c]); }
}
struct GlaOutRegs { bf16x8 a[2]; bf16x8 bb[2][4]; float gi[4][4]; unsigned short rvb[4][4]; float ngv[4]; };
__device__ __forceinline__ void gla_out_load(int item, const bf16* zb, const bf16* gqt, const bf16* gst, const float* gintra, const float* ng, GlaOutRegs& R, int tid) {
    const int bh = item >> 6, c = item & 63, b = bh >> 2, h = bh & 3, m0 = b * SEQ + c * GCH, lane = tid & 63, wave = tid >> 6, l15 = lane & 15, quad = lane >> 4;
    const int tr = wave & 3, half = wave >> 2;
#pragma unroll
    for (int kk = 0; kk < 2; ++kk) { const int k0 = 32 * kk; R.a[kk] = *(const GAS bf16x8*)(gqt + (size_t)(m0 + tr * 16 + l15) * (GH * GDK) + h * GDK + k0 + quad * 8);
#pragma unroll
        for (int i = 0; i < 4; ++i) { const int te = half * 4 + i; R.bb[kk][i] = *(const GAS bf16x8*)(gst + (size_t)item * 8192 + (te * 16 + l15) * GDK + k0 + quad * 8); } }
#pragma unroll
    for (int i = 0; i < 4; ++i) { const int e = (half * 4 + i) * 16 + l15; R.ngv[i] = ng[e];
#pragma unroll
        for (int r = 0; r < 4; ++r) { R.rvb[r][i] = *(const GAS unsigned short*)(zb + (size_t)(m0 + tr * 16 + quad * 4 + r) * ZN + ZC_GR + h * GDV + e);
            R.gi[i][r] = gintra[(size_t)(m0 + tr * 16 + quad * 4 + r) * (GH * GDV) + h * GDV + e]; } }
}
__device__ __forceinline__ void gla_out_compute(int item, const GlaOutRegs& R, bf16* ogla, LAS float* SS, int tid) {
    const int bh = item >> 6, c = item & 63, b = bh >> 2, h = bh & 3, m0 = b * SEQ + c * GCH, lane = tid & 63, wave = tid >> 6, l15 = lane & 15, quad = lane >> 4;
    const int tr = wave & 3, half = wave >> 2;
    f32x4 acc[4];
#pragma unroll
    for (int i = 0; i < 4; ++i) acc[i] = (f32x4){0.f, 0.f, 0.f, 0.f};
#pragma unroll
    for (int kk = 0; kk < 2; ++kk)
#pragma unroll
        for (int i = 0; i < 4; ++i) acc[i] = __builtin_amdgcn_mfma_f32_16x16x32_bf16(R.a[kk], R.bb[kk][i], acc[i], 0, 0, 0);
    float ss[4] = {0.f, 0.f, 0.f, 0.f};
#pragma unroll
    for (int i = 0; i < 4; ++i)
#pragma unroll
        for (int r = 0; r < 4; ++r) { acc[i][r] += R.gi[i][r]; ss[r] += acc[i][r] * acc[i][r]; }
#pragma unroll
    for (int r = 0; r < 4; ++r) { ss[r] += __shfl_xor(ss[r], 1); ss[r] += __shfl_xor(ss[r], 2); ss[r] += __shfl_xor(ss[r], 4); ss[r] += __shfl_xor(ss[r], 8);
        if (l15 == 0) SS[wave * 16 + quad * 4 + r] = ss[r]; }
    __syncthreads();
#pragma unroll
    for (int r = 0; r < 4; ++r) { const float tot = SS[wave * 16 + quad * 4 + r] + SS[(wave ^ 4) * 16 + quad * 4 + r];
        const float rstd = __builtin_amdgcn_rsqf(tot * (1.f / GDV) + RMS_EPS); const size_t row = (size_t)(m0 + tr * 16 + quad * 4 + r);
#pragma unroll
        for (int i = 0; i < 4; ++i) { const int e = (half * 4 + i) * 16 + l15; const float rv = bflo((unsigned)R.rvb[r][i]);
            ogla[row * 2048 + h * GDV + e] = (bf16)f2bf(acc[i][r] * rstd * R.ngv[i] * (rv * sigm(rv))); } }
    __syncthreads();
}
__device__ __forceinline__ void gla_out_item(int item, const bf16* zb, const bf16* gqt, const bf16* gst, const float* gintra, const float* ng, bf16* ogla, LAS float* SS, int tid) {
    GlaOutRegs R; gla_out_load(item, zb, gqt, gst, gintra, ng, R, tid); gla_out_compute(item, R, ogla, SS, tid); }
__device__ __forceinline__ void ffn_fix_task(int grp, int s, const float* edge, const float* fw, bf16* affn) {
    const int c0 = s * 8, colg = 256 * (c0 >> 7) + (c0 & 127);
    const bool first = ((grp * 64) & (SEQ - 1)) == 0;
    float wg[3][8], wv[3][8];
#pragma unroll
    for (int j = 0; j < 3; ++j) { const f32x4 a0 = *(const f32x4*)(fw + (size_t)j * FF2 + c0), a1 = *(const f32x4*)(fw + (size_t)j * FF2 + c0 + 4), b0 = *(const f32x4*)(fw + (size_t)j * FF2 + FF + c0), b1 = *(const f32x4*)(fw + (size_t)j * FF2 + FF + c0 + 4);
#pragma unroll
        for (int i = 0; i < 4; ++i) { wg[j][i] = a0[i]; wg[j][4 + i] = a1[i]; wv[j][i] = b0[i]; wv[j][4 + i] = b1[i]; } }
    float g[4][8], v[4][8];
#pragma unroll
    for (int r = 0; r < 4; ++r) { const bool z = first && r < 2; const float* p = edge + ((size_t)(r < 2 ? grp - 1 : grp) * 4 + (r < 2 ? r : r)) * FF2 + colg;
        const f32x4 a0 = z ? (f32x4){0.f, 0.f, 0.f, 0.f} : *(const GAS f32x4*)p, a1 = z ? (f32x4){0.f, 0.f, 0.f, 0.f} : *(const GAS f32x4*)(p + 4), b0 = z ? (f32x4){0.f, 0.f, 0.f, 0.f} : *(const GAS f32x4*)(p + 128), b1 = z ? (f32x4){0.f, 0.f, 0.f, 0.f} : *(const GAS f32x4*)(p + 132);
#pragma unroll
        for (int i = 0; i < 4; ++i) { g[r][i] = a0[i]; g[r][4 + i] = a1[i]; v[r][i] = b0[i]; v[r][4 + i] = b1[i]; } }
#pragma unroll
    for (int r = 0; r < 2; ++r) { float o[8];
#pragma unroll
        for (int i = 0; i < 8; ++i) { const float ug = wg[0][i] * g[r][i] + wg[1][i] * g[r + 1][i] + wg[2][i] * g[r + 2][i], uv = wv[0][i] * v[r][i] + wv[1][i] * v[r + 1][i] + wv[2][i] * v[r + 2][i]; o[i] = ug * sigm(ug) * uv; }
        *(GAS v4u*)(affn + (size_t)(grp * 64 + r) * FF + c0) = pack8f(o); }
}

#ifndef MK_N_LAUNCHES
#define MK_N_LAUNCHES 1
#endif
constexpr int N_PHASES = 1 + 10 * DEPTH;
struct Args { const float* in[26]; float* out; unsigned char* ws; int ph_lo, ph_hi, one, pad; };
constexpr int PTAB_OFF = LDSCTL_OFF + 1024;
__device__ __forceinline__ unsigned long long ldp_raw(const LAS unsigned long long* tab, int i) {
    const unsigned long long v = tab[i]; const unsigned a = __builtin_amdgcn_readfirstlane((unsigned)v), b = __builtin_amdgcn_readfirstlane((unsigned)(v >> 32));
    return ((unsigned long long)b << 32) | a; }
#define INP(i) ((const float*)(const GAS float*)ldp_raw(PT, (i)))
#define WSB() ((unsigned char*)(GAS unsigned char*)ldp_raw(PT, 27))
#define OUTP() ((float*)(GAS float*)ldp_raw(PT, 26))
#define RSTD_TABLE(S_, part_) do { pg8::Unit uu_; int pmv_[6]; \
        _Pragma("unroll") for (int i_ = 0; i_ < 6; ++i_) pmv_[i_] = S_.next(i_, uu_) ? uu_.pm : -1; \
        { const int row_ = tid & 255, hf_ = tid >> 8; f32x4 v_[6][4];                     \
          _Pragma("unroll") for (int i_ = 0; i_ < 6; ++i_) { const int pm_ = pmv_[i_] < 0 ? (pmv_[0] < 0 ? 0 : pmv_[0]) : pmv_[i_]; const float* p_ = (part_) + (size_t)(pm_ * 256 + row_) * 32 + hf_ * 16; \
              _Pragma("unroll") for (int q_ = 0; q_ < 4; ++q_) v_[i_][q_] = *(const GAS f32x4*)(p_ + 4 * q_); } \
          _Pragma("unroll") for (int i_ = 0; i_ < 6; ++i_) { float s_ = 0.f; _Pragma("unroll") for (int q_ = 0; q_ < 4; ++q_) s_ += (v_[i_][q_][0] + v_[i_][q_][1]) + (v_[i_][q_][2] + v_[i_][q_][3]); \
              ((LAS float*)(L + RING_OFF))[(i_ * 2 + hf_) * 256 + row_] = s_; } } \
        __syncthreads(); \
        for (int j_ = tid; j_ < 6 * 256; j_ += NTHR) { const int i_ = j_ >> 8, r_ = j_ & 255; const LAS float* t_ = (const LAS float*)(L + RING_OFF); \
            ((LAS float*)(L + RT_OFF))[j_] = __builtin_amdgcn_rsqf((t_[(i_ * 2) * 256 + r_] + t_[(i_ * 2 + 1) * 256 + r_]) * (1.0f / DM) + RMS_EPS); } \
        if (tid == 0) { _Pragma("unroll") for (int i_ = 0; i_ < 6; ++i_) if (pmv_[i_] >= 0) ((LAS int*)(L + SLOT_OFF))[pmv_[i_]] = i_; } \
        __syncthreads(); } while (0)
__global__ void __launch_bounds__(NTHR, 2) trunk_fwd(Args args) {
    extern __shared__ __attribute__((aligned(16))) unsigned char lds[];
    LAS unsigned char* L = (LAS unsigned char*)lds;
    volatile LAS unsigned* MISC = (volatile LAS unsigned*)(L + MISC_OFF);
    const LAS unsigned long long* PT = (const LAS unsigned long long*)(L + PTAB_OFF);
    for (int u = threadIdx.x; u < (LDS_BYTES - LDSCTL_OFF) / 4; u += NTHR) ((LAS unsigned*)(L + LDSCTL_OFF))[u] = 0u;
    __syncthreads();
    { const int tid = threadIdx.x;
    if (tid < 26) ((LAS unsigned long long*)(L + PTAB_OFF))[tid] = (unsigned long long)args.in[tid];
    if (tid == 26) ((LAS unsigned long long*)(L + PTAB_OFF))[26] = (unsigned long long)args.out;
    if (tid == 27) ((LAS unsigned long long*)(L + PTAB_OFF))[27] = (unsigned long long)args.ws; }
    __syncthreads();
    XcdBarrier bar; bar.bar = (unsigned*)(args.ws + WS_CTL) + CW_BAR; bar.x = 0; bar.st = nullptr;
    if (args.one) bar = xcd_barrier_post((unsigned*)(args.ws + WS_CTL) + CW_BAR, MISC + 8);
    const int lo = args.ph_lo, hi = args.ph_hi;
#ifndef PHMASK
#define PHMASK 0xFFFF
#endif
#define IN(k) (lo <= (k) && (k) < hi)
#define EN(b) (((PHMASK) >> (b)) & 1)
#define SEAM(k) do { if (IN(k) && IN((k) + 1)) xcd_barrier(bar); } while (0)
#define GRIDV() int tid = threadIdx.x; asm volatile("" : "+v"(tid)); const int lane = tid & 63, wave = __builtin_amdgcn_readfirstlane(tid >> 6); (void)lane; (void)wave; const int G = gridDim.x, bx = blockIdx.x; const int vcu = (G % 8 == 0) ? (bx % 8) * (G / 8) + bx / 8 : bx; (void)vcu
#define WP(T_, off) ((T_*)(ws + (off)))

    if (EN(0) && IN(0)) {
        GRIDV(); unsigned char* ws = WSB(); const int gw = vcu * NWAVES + wave, NGW = G * NWAVES;
        {
#define CV_DECODE(id_, tl_) do { const int l_ = (id_) / CT_LAYER; int r_ = (id_) - l_ * CT_LAYER; unsigned char* wl_ = ws + WS_W + (size_t)l_ * W_LAYER; int ng_; \
            if (r_ < CT_IN) { tl_.W = INP(3) + (size_t)l_ * DM * IN_COLS; tl_.K = DM; tl_.N = IN_COLS; tl_.gain = INP(2) + l_ * DM; tl_.WT = (bf16*)(wl_ + WO_W1); tl_.ldk = tl_.K; tl_.map = MAP_IN; tl_.off = 0; ng_ = 44; } \
            else if ((r_ -= CT_IN) < CT_GT) { tl_.W = INP(16) + (size_t)l_ * DM * NGATE; tl_.K = DM; tl_.N = NGATE; tl_.gain = INP(2) + l_ * DM; tl_.WT = (bf16*)(wl_ + WO_W1); tl_.ldk = tl_.K; tl_.map = MAP_ID; tl_.off = ZC_GATE; ng_ = 48; } \
            else if ((r_ -= CT_GT) < CT_CA) { tl_.W = INP(8) + (size_t)l_ * CCH * DM; tl_.K = CCH; tl_.N = DM; tl_.gain = nullptr; tl_.WT = (bf16*)(wl_ + WO_CA); tl_.ldk = 2048; tl_.map = MAP_ID; tl_.off = 0; ng_ = 16; } \
            else if ((r_ -= CT_CA) < CT_GL) { tl_.W = INP(12) + (size_t)l_ * 512 * DM; tl_.K = 512; tl_.N = DM; tl_.gain = nullptr; tl_.WT = (bf16*)(wl_ + WO_CA) + 512; tl_.ldk = 2048; tl_.map = MAP_ID; tl_.off = 0; ng_ = 16; } \
            else if ((r_ -= CT_GL) < CT_MO) { tl_.W = INP(15) + (size_t)l_ * 1024 * DM; tl_.K = 1024; tl_.N = DM; tl_.gain = nullptr; tl_.WT = (bf16*)(wl_ + WO_CA) + 1024; tl_.ldk = 2048; tl_.map = MAP_ID; tl_.off = 0; ng_ = 16; } \
            else if ((r_ -= CT_MO) < CT_OU) { tl_.W = INP(18) + (size_t)l_ * DM * DM; tl_.K = DM; tl_.N = DM; tl_.gain = nullptr; tl_.WT = (bf16*)(wl_ + WO_OU); tl_.ldk = tl_.K; tl_.map = MAP_ID; tl_.off = 0; ng_ = 16; } \
            else if ((r_ -= CT_OU) < CT_UP) { tl_.W = INP(20) + (size_t)l_ * DM * FF2; tl_.K = DM; tl_.N = FF2; tl_.gain = INP(19) + l_ * DM; tl_.WT = (bf16*)(wl_ + WO_UP); tl_.ldk = tl_.K; tl_.map = MAP_UP; tl_.off = 0; ng_ = 88; } \
            else if ((r_ -= CT_UP) < CT_DN) { tl_.W = INP(22) + (size_t)l_ * FF * DM; tl_.K = FF; tl_.N = DM; tl_.gain = nullptr; tl_.WT = (bf16*)(wl_ + WO_DN); tl_.ldk = tl_.K; tl_.map = MAP_ID; tl_.off = 0; ng_ = 16; } \
            else if ((r_ -= CT_DN) < CT_PG) { tl_.W = INP(24) + (size_t)l_ * DM * DM; tl_.K = DM; tl_.N = DM; tl_.gain = INP(23) + l_ * DM; tl_.WT = (bf16*)(wl_ + WO_PG); tl_.ldk = tl_.K; tl_.map = MAP_ID; tl_.off = 0; ng_ = 16; } \
            else { r_ -= CT_PG; tl_.W = INP(25) + (size_t)l_ * PLE * DM; tl_.K = PLE; tl_.N = DM; tl_.gain = nullptr; tl_.WT = (bf16*)(wl_ + WO_PL); tl_.ldk = tl_.K; tl_.map = MAP_ID; tl_.off = 0; ng_ = 16; } \
            { const int kb_ = r_ / ng_; tl_.k0 = 64 * kb_; tl_.n0 = 128 * (r_ - kb_ * ng_); } } while (0)
#define CV_ISSUE(i_) do { CvTile ti_; CV_DECODE(vcu + (i_) * G, ti_); \
            _Pragma("unroll") for (int j_ = 0; j_ < 4; ++j_) { const int p_ = wave * 4 + j_; \
                __builtin_amdgcn_global_load_lds((const unsigned*)(ti_.W + (size_t)(ti_.k0 + 2 * p_ + (lane >> 5)) * ti_.N + ti_.n0 + (lane & 31) * 4), \
                                                 (LAS unsigned*)(L + RING_OFF + ((i_) & 3) * 32768 + p_ * 1024), 16, 0, 2); } } while (0)
            const int ntl = (DEPTH * CT_LAYER - vcu + G - 1) / G;
            for (int i = 0; i < 3 && i < ntl; ++i) CV_ISSUE(i);
            const int c = tid & 127, kq = __builtin_amdgcn_readfirstlane(tid >> 7);
            for (int i = 0; i < ntl; ++i) {
                if (i + 3 >= ntl) asm volatile("s_waitcnt vmcnt(0)" ::: "memory");
                else if (i == 0) asm volatile("s_waitcnt vmcnt(8)" ::: "memory");
                else if (i == 1) asm volatile("s_waitcnt vmcnt(10)" ::: "memory");
                else if (i == 2) asm volatile("s_waitcnt vmcnt(12)" ::: "memory");
                else asm volatile("s_waitcnt vmcnt(14)" ::: "memory");
                __builtin_amdgcn_s_barrier(); asm volatile("" ::: "memory");
                if (i + 3 < ntl) CV_ISSUE(i + 3);
                CvTile tc; CV_DECODE(vcu + i * G, tc);
                const LAS float* sp = (const LAS float*)(L + RING_OFF + (i & 3) * 32768) + (kq * 16) * 128 + c;
                float v[16];
#pragma unroll
                for (int r = 0; r < 16; ++r) v[r] = sp[r * 128];
                if (tc.gain) {
#pragma unroll
                    for (int r = 0; r < 16; ++r) v[r] *= ((const __attribute__((address_space(4))) float*)(unsigned long long)tc.gain)[tc.k0 + kq * 16 + r]; }
                bf16* dp = tc.WT + (size_t)map_col_rt(tc.map, tc.n0 + c, tc.off) * tc.ldk + tc.k0 + kq * 16;
                v4u o0, o1; o0.x = pk2(v[0], v[1]); o0.y = pk2(v[2], v[3]); o0.z = pk2(v[4], v[5]); o0.w = pk2(v[6], v[7]); o1.x = pk2(v[8], v[9]); o1.y = pk2(v[10], v[11]); o1.z = pk2(v[12], v[13]); o1.w = pk2(v[14], v[15]);
                *(GAS v4u*)dp = o0; *(GAS v4u*)(dp + 8) = o1;
            }
            asm volatile("s_waitcnt vmcnt(0)" ::: "memory"); __syncthreads();
#undef CV_ISSUE
#undef CV_DECODE
            for (int it = gw; it < DEPTH * 32; it += NGW) { const int l = it >> 5, kb = it & 31;
                tr2_item<MAP_IN>(INP(3) + (size_t)l * DM * IN_COLS, DM, IN_COLS, INP(2) + l * DM, (bf16*)(ws + WS_W + (size_t)l * W_LAYER + WO_W1), 0, kb * 89 + 88, lane); }
        }
        const size_t gt = (size_t)vcu * NTHR + tid, NGT = (size_t)G * NTHR;
        for (size_t i = gt; i < (size_t)DEPTH * 240 * (DM / 8); i += NGT) {
            const int l = (int)(i / (240 * (DM / 8))); const size_t r = i - (size_t)l * (240 * (DM / 8));
            *(GAS v4u*)(ws + WS_W + (size_t)l * W_LAYER + WO_W1 + ((size_t)(ZC_GA + 16) * DM + r * 8) * 2) = (v4u){0u, 0u, 0u, 0u}; }
        const float* x_in = INP(0); bf16* XBA = WP(bf16, WS_XBA); float* ROWSS = WP(float, WS_RSP);
        for (int m = gw; m < T; m += NGW) {
            const GAS f32x4* xr = (const GAS f32x4*)(x_in + (size_t)m * DM) + lane; float s = 0.f;
#pragma unroll
            for (int j = 0; j < 8; ++j) { const f32x4 v = xr[64 * j]; s += (v.x * v.x + v.y * v.y) + (v.z * v.z + v.w * v.w);
                *((GAS unsigned long long*)(XBA + (size_t)m * DM) + lane + 64 * j) = (unsigned long long)pk2(v.x, v.y) | ((unsigned long long)pk2(v.z, v.w) << 32); }
            s = wave_sum(s); if (lane < 32) ROWSS[(size_t)m * 32 + lane] = lane == 0 ? s : 0.f; }
        const float* p_in = INP(1); bf16* PB = WP(bf16, WS_PB);
        for (size_t i = gt; i < (size_t)DEPTH * T * PLE / 8; i += NGT) {
            const GAS f32x4* pp = (const GAS f32x4*)(p_in) + 2 * i; const f32x4 a = pp[0], b = pp[1];
            v4u o; o.x = pk2(a.x, a.y); o.y = pk2(a.z, a.w); o.z = pk2(b.x, b.y); o.w = pk2(b.z, b.w); *((GAS v4u*)PB + i) = o; }
    }
    SEAM(0);
    for (int l = 0; l < DEPTH; ++l) {
        const int p0 = 1 + 10 * l;
        if (EN(1) && IN(p0 + 0)) {
            GRIDV(); unsigned char* ws = WSB(); unsigned char* wl = ws + WS_W + (size_t)l * W_LAYER;
            pg8::Gemm g{WP(bf16, WS_XBA), (const bf16*)(wl + WO_W1), T, ZN, DM}; pg8::StaticOrder S; S.init(T, ZN, G, bx);
            RSTD_TABLE(S, WP(float, WS_RSP) + (size_t)(3 * l) * T * 32);
            pg8::EpiIn E{WP(bf16, WS_ZB), ZN, WP(bf16, WS_AGLU), WP(float, WS_RSP) + (size_t)(3 * l) * T * 32, 1.0f / DM, INP(17) + (size_t)l * NGATE, WP(float, WS_GA), INP(13) + l * MHD, INP(14) + l * MHD, (LAS float*)(L + XL_OFF), WP(bf16, WS_QKV), SEQ, (const LAS float*)(L + RT_OFF), (const LAS int*)(L + SLOT_OFF)};
            pg8::gemm_phase<pg8::EpiIn, pg8::StaticOrder, true, true>(L + RING_OFF, g, S, E);
        }
        SEAM(p0 + 0);
        if (EN(2) && IN(p0 + 1)) {
            GRIDV(); unsigned char* ws = WSB(); bf16* ZB = WP(bf16, WS_ZB);
            { const float* cw = INP(4) + (size_t)l * CWID * CCH; const float* cb = INP(5) + l * CCH; const float* lg = INP(6) + l * CCH; const float* lb = INP(7) + l * CCH;
              for (int it = vcu; it < 256; it += G) conv_branch_item(it, WP(bf16, WS_AGLU), cw, cb, lg, lb, WP(bf16, WS_ACAT), (LAS float*)(L + RING_OFF), tid); }
            for (int it = vcu; it < 256; it += G) kmean_item(it, WP(bf16, WS_QKV), WP(float, WS_KMEAN), (LAS float*)(L + RING_OFF), tid);
            { const float* wa2 = INP(9) + (size_t)l * GRANK * GH * GDK; const float* ba = INP(10) + l * GH * GDK;
              int it = vcu;
              for (; it + G < 512; it += 2 * G) { GlaLocRegs R0, R1; gla_local_load(it, ZB, WP(float, WS_GA), R0, tid); gla_local_load(it + G, ZB, WP(float, WS_GA), R1, tid);
                  gla_local_compute(it, R0, wa2, ba, WP(bf16, WS_GQT), WP(float, WS_GINTRA), WP(float, WS_GDELTA), WP(float, WS_GDEC), L + RING_OFF, tid);
                  gla_local_compute(it + G, R1, wa2, ba, WP(bf16, WS_GQT), WP(float, WS_GINTRA), WP(float, WS_GDELTA), WP(float, WS_GDEC), L + RING_OFF, tid); }
              for (; it < 512; it += G) gla_local_item(it, ZB, WP(float, WS_GA), wa2, ba, WP(bf16, WS_GQT), WP(float, WS_GINTRA), WP(float, WS_GDELTA), WP(float, WS_GDEC), L + RING_OFF, tid); }
        }
        SEAM(p0 + 1);
        if (EN(3) && IN(p0 + 2)) {
            GRIDV(); unsigned char* ws = WSB();
#define GLA_SCAN_ALL() do { if (tid < 256) for (int g_ = vcu * 256 + tid; g_ < BATCH * GH * GDK * GDV; g_ += G * 256) gla_scan(g_, WP(float, WS_GDELTA), WP(float, WS_GDEC), WP(bf16, WS_GST)); } while (0)
            if (bx >= BATCH * MH * MNB) GLA_SCAN_ALL();
            for (int u = bx; u < BATCH * MH * MNB; u += G) {
                const int xg = u & 7, i = u >> 3, bh = (xg * 2 + (i >> 4)) & 15, t = i & 15, b = bh >> 3, h = bh & 7;
                const int sA = t + 1, jA = sA - 1, sB = 16 - t, jB = sB - 1;
                const bf16* qh = WP(bf16, WS_QKV) + (size_t)((0 * BATCH + b) * MH + h) * SEQ * MHD; const bf16* kh = WP(bf16, WS_QKV) + (size_t)((1 * BATCH + b) * MH + h) * SEQ * MHD; const bf16* vh = WP(bf16, WS_QKV) + (size_t)((2 * BATCH + b) * MH + h) * SEQ * MHD; const float* km = WP(float, WS_KMEAN) + (size_t)(b * MH + h) * MNB * MHD;
                moba::BlockRef pa{qh + (size_t)(jA * MBLK) * MHD, kh, vh,
                                  WP(bf16, WS_OMOBA) + (size_t)(b * SEQ + jA * MBLK) * (MH * MHD) + h * MHD, km, WP(float, WS_ML) + ((size_t)(b * SEQ + jA * MBLK) * 8 + h) * 2, jA, 0, 2 * sA};
                moba::BlockRef pb{qh + (size_t)(jB * MBLK) * MHD, kh, vh,
                                  WP(bf16, WS_OP1) + (size_t)(b * SEQ + jB * MBLK) * (MH * MHD) + h * MHD, km, WP(float, WS_ML) + ((size_t)T * 8 + (size_t)(b * SEQ + jB * MBLK) * 8 + h) * 2, jB, 2 * sB, 4 * sB};
                moba::Seam S;
                moba::moba_prime<MHD>(pa, (char*)lds + RING_OFF, S, [&]() { if (u == bx) GLA_SCAN_ALL(); });
                moba::moba_block<MHD, MH * MHD>(pa, pb, (char*)lds + RING_OFF, S);
                moba::moba_block<MHD, MH * MHD>(pb, pb, (char*)lds + RING_OFF, S);
            }
#undef GLA_SCAN_ALL
        }
        SEAM(p0 + 2);
        if (EN(4) && IN(p0 + 3)) {
            GRIDV(); unsigned char* ws = WSB();
            for (size_t i = (size_t)vcu * NTHR + tid; i < (size_t)T * MH * MHD / 8; i += (size_t)G * NTHR) moba_combine(i, WP(bf16, WS_OMOBA), WP(bf16, WS_OP1), WP(float, WS_ML), WP(bf16, WS_ACAT) + 1024);
            { const float* ng = INP(11) + l * GDV;
              int it = vcu;
              for (; it + G < 512; it += 2 * G) { GlaOutRegs R0, R1;
                  gla_out_load(it, WP(bf16, WS_ZB), WP(bf16, WS_GQT), WP(bf16, WS_GST), WP(float, WS_GINTRA), ng, R0, tid); gla_out_load(it + G, WP(bf16, WS_ZB), WP(bf16, WS_GQT), WP(bf16, WS_GST), WP(float, WS_GINTRA), ng, R1, tid);
                  gla_out_compute(it, R0, WP(bf16, WS_ACAT) + 512, (LAS float*)(L + RING_OFF), tid); gla_out_compute(it + G, R1, WP(bf16, WS_ACAT) + 512, (LAS float*)(L + RING_OFF), tid); }
              for (; it < 512; it += G) gla_out_item(it, WP(bf16, WS_ZB), WP(bf16, WS_GQT), WP(bf16, WS_GST), WP(float, WS_GINTRA), ng, WP(bf16, WS_ACAT) + 512, (LAS float*)(L + RING_OFF), tid); }
        }
        SEAM(p0 + 3);
        if (EN(5) && IN(p0 + 4)) {
            GRIDV(); unsigned char* ws = WSB(); unsigned char* wl = ws + WS_W + (size_t)l * W_LAYER;
            pg8::Gemm g{WP(bf16, WS_ACAT), (const bf16*)(wl + WO_CA), T, DM, DM}; pg8::StaticOrder S; S.init(T, DM, G, bx);
            pg8::EpiMerge3 E{(const unsigned char*)(ws + WS_G8), NGATE, 0, WP(bf16, WS_MRG), DM};
            static_assert(WS_G8 - WS_ZB == 580911104ull && NGATE == 6144, "EpiIn derives the u8 gate buffer from the zb pointer");
            pg8::gemm_phase<pg8::EpiMerge3, pg8::StaticOrder, true, true>(L + RING_OFF, g, S, E);
        }
        SEAM(p0 + 4);
        if (EN(7) && IN(p0 + 5)) {
            GRIDV(); unsigned char* ws = WSB(); unsigned char* wl = ws + WS_W + (size_t)l * W_LAYER; float* xres = OUTP();
            pg8::Gemm g{WP(bf16, WS_MRG), (const bf16*)(wl + WO_OU), T, DM, DM}; pg8::StaticOrder S; S.init(T, DM, G, bx);
            pg8::EpiRes<false> E{WP(bf16, WS_XBA), WP(bf16, WS_XBB), nullptr, WP(float, WS_RSP) + (size_t)(3 * l + 1) * T * 32, nullptr, 0.f, nullptr, DM};
            pg8::gemm_phase<pg8::EpiRes<false>, pg8::StaticOrder, true, true>(L + RING_OFF, g, S, E);
        }
        SEAM(p0 + 5);
        if (EN(8) && IN(p0 + 6)) {
            GRIDV(); unsigned char* ws = WSB(); unsigned char* wl = ws + WS_W + (size_t)l * W_LAYER;
            pg8::Gemm g{WP(bf16, WS_XBB), (const bf16*)(wl + WO_UP), T, FF2, DM}; pg8::StaticOrder S; S.init(T, FF2, G, bx);
            RSTD_TABLE(S, WP(float, WS_RSP) + (size_t)(3 * l + 1) * T * 32);
            pg8::EpiFfn E{WP(bf16, WS_TMP), FF, INP(21) + (size_t)l * 3 * FF2, WP(float, WS_EDGE), (const LAS float*)(L + RT_OFF), (const LAS int*)(L + SLOT_OFF), (LAS float*)(L + XL_OFF)};
            pg8::gemm_phase<pg8::EpiFfn, pg8::StaticOrder, true, true>(L + RING_OFF, g, S, E);
        }
        if (EN(9) && IN(p0 + 6)) {
            GRIDV(); unsigned char* ws = WSB(); unsigned char* wl = ws + WS_W + (size_t)l * W_LAYER;
            int kple = PLE; asm volatile("" : "+s"(kple));
            pg8::Gemm g2{WP(bf16, WS_PB) + (size_t)l * T * PLE, (const bf16*)(wl + WO_PL), T, DM, kple}; pg8::TailOrder S2; S2.init(T, DM, G >= 256 ? 128 : 0, G >= 256 ? 2 : (256 + G - 1) / G, bx);
            pg8::EpiZ E2{WP(bf16, WS_PE), DM, nullptr, 0.f, nullptr, 1 << 30, 1 << 30, -1, nullptr};
            pg8::gemm_phase<pg8::EpiZ, pg8::TailOrder, true, true>(L + RING_OFF, g2, S2, E2);
        }
        SEAM(p0 + 6);
        if (EN(13) && IN(p0 + 8)) {
            GRIDV(); unsigned char* ws = WSB(); const float* fw = INP(21) + (size_t)l * 3 * FF2;
            pg8::StaticOrder S; S.init(T, DM, G, bx); pg8::Unit uu;
            for (int i = 0; S.next(i, uu); ++i) for (int s = tid; s < FF / 8; s += NTHR) ffn_fix_task(uu.pm * 4, s, WP(float, WS_EDGE), fw, WP(bf16, WS_TMP));
            asm volatile("s_waitcnt vmcnt(0)" ::: "memory"); __syncthreads();
        }
        if (EN(10) && IN(p0 + 8)) {
            GRIDV(); unsigned char* ws = WSB(); unsigned char* wl = ws + WS_W + (size_t)l * W_LAYER; float* xres = OUTP();
            pg8::Gemm g{WP(bf16, WS_TMP), (const bf16*)(wl + WO_DN), T, DM, FF}; pg8::StaticOrder S; S.init(T, DM, G, bx);
            pg8::EpiRes<false> E{WP(bf16, WS_XBB), WP(bf16, WS_XBC), nullptr, WP(float, WS_RSP) + (size_t)(3 * l + 2) * T * 32, nullptr, 0.f, nullptr, DM};
            pg8::gemm_phase<pg8::EpiRes<false>, pg8::StaticOrder, true, true>(L + RING_OFF, g, S, E);
        }
        SEAM(p0 + 8);
        if (EN(11) && IN(p0 + 9)) {
            GRIDV(); unsigned char* ws = WSB(); unsigned char* wl = ws + WS_W + (size_t)l * W_LAYER; float* xres = OUTP();
            pg8::Gemm g{WP(bf16, WS_XBC), (const bf16*)(wl + WO_PG), T, DM, DM}; pg8::StaticOrder S; S.init(T, DM, G, bx);
            pg8::EpiRes<true> E{WP(bf16, WS_XBC), WP(bf16, WS_XBA), l == DEPTH - 1 ? xres : nullptr, WP(float, WS_RSP) + (size_t)(3 * l + 3) * T * 32, WP(float, WS_RSP) + (size_t)(3 * l + 2) * T * 32, 1.0f / DM, WP(bf16, WS_PE), DM};
            pg8::gemm_phase<pg8::EpiRes<true>, pg8::StaticOrder, true, true>(L + RING_OFF, g, S, E);
        }
        SEAM(p0 + 9);
    }
#undef IN
#undef SEAM
}

extern "C" void kernel_launch(void* const* d_in, const int* in_sizes, int n_in, void* d_out, int out_size, void* d_ws, size_t ws_size, hipStream_t stream) {
    static int grid = 0;
    if (grid == 0) {
        if (n_in != 26 || out_size != T * DM || ws_size < WS_END) { fprintf(stderr, "kernel_launch: unexpected problem (n_in %d, out %d, ws %zu < %zu); nothing launched\n", n_in, out_size, ws_size, (size_t)WS_END); grid = -1; return; }
        int dev = 0, cus = 0, per_cu = 0;
        if (hipGetDevice(&dev) != hipSuccess || hipDeviceGetAttribute(&cus, hipDeviceAttributeMultiprocessorCount, dev) != hipSuccess) { grid = -1; return; }
        if (hipFuncSetAttribute((const void*)trunk_fwd, hipFuncAttributeMaxDynamicSharedMemorySize, LDS_BYTES) != hipSuccess) { fprintf(stderr, "kernel_launch: hipFuncSetAttribute failed\n"); grid = -1; return; }
        if (hipOccupancyMaxActiveBlocksPerMultiprocessor(&per_cu, (const void*)trunk_fwd, NTHR, LDS_BYTES) != hipSuccess || per_cu < 1) { fprintf(stderr, "kernel_launch: occupancy query says %d\n", per_cu); (void)hipGetLastError(); per_cu = 1; }
        grid = cus;
        if (grid > 256) grid = 256;
    }
    if (grid < 0) return;
    (void)hipMemsetAsync((char*)d_ws + WS_CTL, 0, CTL_ZERO_BYTES, stream);
    Args a{};
    for (int i = 0; i < 26; ++i) a.in[i] = (const float*)d_in[i];
    a.out = (float*)d_out; a.ws = (unsigned char*)d_ws; a.pad = 0;
#if MK_N_LAUNCHES == 1
    a.ph_lo = 0; a.ph_hi = N_PHASES; a.one = 1;
    hipLaunchKernelGGL(trunk_fwd, dim3(grid), dim3(NTHR), LDS_BYTES, stream, a);
#else
    for (int p = 0; p < N_PHASES; ++p) { a.ph_lo = p; a.ph_hi = p + 1; a.one = 0; hipLaunchKernelGGL(trunk_fwd, dim3(grid), dim3(NTHR), LDS_BYTES, stream, a); }
#endif
}
```

```cpp
#include <hip/hip_runtime.h>
#include <cstdio>
#include <cstdint>
namespace pg8 {
#define PG8_LAS __attribute__((address_space(3)))
typedef unsigned short bf16_t;
typedef short bf16x8 __attribute__((ext_vector_type(8)));
typedef float f32x4 __attribute__((ext_vector_type(4)));
typedef unsigned u32x4 __attribute__((ext_vector_type(4)));
constexpr int BM = 256, BK = 64, HALF = 128, HTB = HALF * BK * 2  , STAGE_BYTES = 8 * HTB, NXCD = 8, WGM = 8;

__host__ __device__ __forceinline__ int lds_byte(int r, int c) { const int st = (r >> 4) * 2 + (c >> 5), rr = r & 15, cc = c & 31, ob = rr * 64 + cc * 2; return st * 1024 + (ob ^ (((ob >> 9) & 1) << 5)); }
__host__ __device__ __forceinline__ void stage_rc(int b, int& R, int& C) { const int st = b / 1024, sb = b % 1024, swz = sb ^ (((sb >> 9) & 1) << 5); R = (st >> 1) * 16 + swz / 64; C = (st & 1) * 32 + (swz % 64) / 2; }
__host__ __device__ __forceinline__ int perm32(int rho) { const int n = rho >> 4, i = rho & 15; return 8 * (i >> 2) + 4 * n + (i & 3); }

struct Unit { int pm, pn; };
struct Gemm { const bf16_t* A; const bf16_t* Bt; int M, N, K; };

struct StaticOrder {
    int nM, nN, nwg, G, c;
    __host__ __device__ void init(int M, int N, int G_, int c_) { nM = M / BM; nN = N / BM; nwg = nM * nN; G = G_; c = c_; }
    __host__ __device__ __forceinline__ bool next(int i, Unit& u) const {
        const long L = (long)i * G + c; if (L >= nwg) return false;
        int wgid = (int)L; { const int q = nwg / NXCD, r = nwg % NXCD, xcd = wgid % NXCD, off = wgid / NXCD; wgid = (xcd < r ? xcd * (q + 1) : r * (q + 1) + (xcd - r) * q) + off; }
        const int nig = WGM * nN, gid = wgid / nig, fm = gid * WGM, gsz = (nM - fm) < WGM ? (nM - fm) : WGM;
        u.pm = fm + ((wgid % nig) % gsz); u.pn = (wgid % nig) / gsz; return true;
    }
    __device__ __forceinline__ void a_ready(const Unit&) const {}
    __device__ __forceinline__ void done(const Unit&) const {}
};

struct TailOrder {
    int nM, nN, nwg, first, per, c;
    __host__ __device__ void init(int M, int N, int first_, int per_, int c_) { nM = M / BM; nN = N / BM; nwg = nM * nN; first = first_; per = per_; c = c_; }
    __host__ __device__ __forceinline__ bool next(int i, Unit& u) const { if (c < first || i >= per) return false; const int id = per * (c - first) + i; if (id >= nwg) return false; u.pm = id / nN; u.pn = id - u.pm * nN; return true; }
    __device__ __forceinline__ void a_ready(const Unit&) const {}
    __device__ __forceinline__ void done(const Unit&) const {}
};

__device__ __forceinline__ unsigned cvt_pk_bf16(float lo, float hi) { unsigned r; asm volatile("v_cvt_pk_bf16_f32 %0, %1, %2" : "=v"(r) : "v"(lo), "v"(hi)); return r; }
typedef float f32x2 __attribute__((ext_vector_type(2)));
constexpr float RMS_EPS = 1e-6f;
__device__ __forceinline__ float sigm(float v) { return __builtin_amdgcn_rcpf(1.0f + __builtin_amdgcn_exp2f(-1.4426950408889634f * v)); }
__device__ __forceinline__ f32x4 sigm4(const f32x4 v) { const f32x4 t = v * -1.4426950408889634f; f32x4 e;
#pragma unroll
    for (int j = 0; j < 4; ++j) e[j] = __builtin_amdgcn_exp2f(t[j]);
    const f32x4 d = e + 1.0f; f32x4 r;
#pragma unroll
    for (int j = 0; j < 4; ++j) r[j] = __builtin_amdgcn_rcpf(d[j]);
    return r; }
__device__ __forceinline__ f32x4 sexp4s(const f32x4 t, const float inv_s) { f32x4 e;
#pragma unroll
    for (int j = 0; j < 4; ++j) e[j] = __builtin_amdgcn_exp2f(t[j]);
    const f32x4 d = e * inv_s + inv_s; f32x4 r;
#pragma unroll
    for (int j = 0; j < 4; ++j) r[j] = __builtin_amdgcn_rcpf(d[j]);
    return r; }
__device__ __forceinline__ f32x4 sigm4s(const f32x4 v, const float inv_s) { const f32x4 t = v * -1.4426950408889634f; f32x4 e;
#pragma unroll
    for (int j = 0; j < 4; ++j) e[j] = __builtin_amdgcn_exp2f(t[j]);
    const f32x4 d = e * inv_s + inv_s; f32x4 r;
#pragma unroll
    for (int j = 0; j < 4; ++j) r[j] = __builtin_amdgcn_rcpf(d[j]);
    return r; }
__device__ __forceinline__ float bf_lo(unsigned w) { return __uint_as_float(w << 16); }
__device__ __forceinline__ float bf_hi(unsigned w) { return __uint_as_float(w & 0xffff0000u); }
__device__ __forceinline__ float row_rstd(const float* part, size_t row, int fq, float inv_k) {
    const f32x4 a = *(const f32x4*)(part + row * 32 + fq * 8), b = *(const f32x4*)(part + row * 32 + fq * 8 + 4);
    float s = ((a[0] + a[1]) + (a[2] + a[3])) + ((b[0] + b[1]) + (b[2] + b[3]));
    s += __shfl_xor(s, 16); s += __shfl_xor(s, 32);
    return __builtin_amdgcn_rsqf(s * inv_k + RMS_EPS);
}
__device__ __forceinline__ void row_rstd8(float (&rs)[2][4], const float* part, int row0, int fq, float inv_k) {
    f32x4 a[2][4], b[2][4];
#pragma unroll
    for (int ai = 0; ai < 2; ++ai)
#pragma unroll
        for (int m = 0; m < 4; ++m) { const float* p = part + (size_t)(row0 + ai * HALF + m * 16) * 32 + fq * 8; a[ai][m] = *(const f32x4*)p; b[ai][m] = *(const f32x4*)(p + 4); }
#pragma unroll
    for (int ai = 0; ai < 2; ++ai)
#pragma unroll
        for (int m = 0; m < 4; ++m) { float s = ((a[ai][m][0] + a[ai][m][1]) + (a[ai][m][2] + a[ai][m][3])) + ((b[ai][m][0] + b[ai][m][1]) + (b[ai][m][2] + b[ai][m][3]));
            s += __shfl_xor(s, 16); s += __shfl_xor(s, 32); rs[ai][m] = __builtin_amdgcn_rsqf(s * inv_k + RMS_EPS); }
}
__device__ __forceinline__ void row_rstd4(float (&rs)[4], const float* part, int rowb, int fq, float inv_k) {
    f32x4 a[4], b[4];
#pragma unroll
    for (int m = 0; m < 4; ++m) { const float* p = part + (size_t)(rowb + m * 16) * 32 + fq * 8; a[m] = *(const f32x4*)p; b[m] = *(const f32x4*)(p + 4); }
#pragma unroll
    for (int m = 0; m < 4; ++m) { float s = ((a[m][0] + a[m][1]) + (a[m][2] + a[m][3])) + ((b[m][0] + b[m][1]) + (b[m][2] + b[m][3]));
        s += __shfl_xor(s, 16); s += __shfl_xor(s, 32); rs[m] = __builtin_amdgcn_rsqf(s * inv_k + RMS_EPS); }
}
struct EpiZ {
    static constexpr bool PERM = true, AFTER_DRAIN = false, PERMA = false, SEGS = false;
    bf16_t* O; int ldc; const float* rowss; float inv_k; const float* bias; int sig_lo, sig_hi, ga_pn; float* ga;
    __device__ __forceinline__ void operator()(const f32x4 (&acc)[2][2][4][2], const Unit& u, int wr, int wc, int fr, int fq) const {
        const int row0 = u.pm * BM + wr * 64 + fr, col0 = u.pn * BM + wc * 32 + 8 * fq;
        float rs[2][4];
        if (rowss) row_rstd8(rs, rowss, row0, fq, inv_k);
        else {
#pragma unroll
            for (int ai = 0; ai < 2; ++ai)
#pragma unroll
                for (int m = 0; m < 4; ++m) rs[ai][m] = 1.0f; }
        if (u.pn == ga_pn) {
            if (wc == 0 && fq < 2) {
#pragma unroll
                for (int ai = 0; ai < 2; ++ai)
#pragma unroll
                    for (int m = 0; m < 4; ++m) { float* gp = ga + (size_t)(row0 + ai * HALF + m * 16) * 16 + 8 * fq;
                        *(f32x4*)gp = acc[ai][0][m][0] * rs[ai][m]; *(f32x4*)(gp + 4) = acc[ai][0][m][1] * rs[ai][m]; }
            }
            return;
        }
        const bool sg = (u.pn >= sig_lo) && (u.pn < sig_hi);
        f32x4 bv[2][2];
#pragma unroll
        for (int bj = 0; bj < 2; ++bj)
#pragma unroll
            for (int n = 0; n < 2; ++n) bv[bj][n] = sg ? *(const f32x4*)(bias + (col0 - sig_lo * BM) + bj * HALF + 4 * n) : (f32x4){0.f, 0.f, 0.f, 0.f};
#pragma unroll
        for (int ai = 0; ai < 2; ++ai)
#pragma unroll
            for (int m = 0; m < 4; ++m) { bf16_t* rowp = O + (size_t)(row0 + ai * HALF + m * 16) * ldc + col0; const float r = rs[ai][m];
#pragma unroll
                for (int bj = 0; bj < 2; ++bj) { f32x4 v0 = acc[ai][bj][m][0] * r + bv[bj][0], v1 = acc[ai][bj][m][1] * r + bv[bj][1];
                    if (sg) {
                        { v0 = sigm4(v0); v1 = sigm4(v1); } }
                    u32x4 w; w.x = cvt_pk_bf16(v0[0], v0[1]); w.y = cvt_pk_bf16(v0[2], v0[3]); w.z = cvt_pk_bf16(v1[0], v1[1]); w.w = cvt_pk_bf16(v1[2], v1[3]);
                    *(u32x4*)(rowp + bj * HALF) = w; } }
    }
};
struct EpiIn {
    static constexpr bool PERM = true, AFTER_DRAIN = false, PERMA = false, SEGS = false;
    bf16_t* Z; int ldc; bf16_t* aglu; const float* rowss; float inv_k; const float* bgate; float* ga; const float* qg; const float* kg; PG8_LAS float* xl; bf16_t* qkv; int seq; const PG8_LAS float* rt; const PG8_LAS int* slot;
    __device__ __forceinline__ void operator()(const f32x4 (&acc)[2][2][4][2], const Unit& u, int wr, int wc, int fr, int fq) const {
        const int row0 = u.pm * BM + wr * 64 + fr, col0 = u.pn * BM + wc * 32 + 8 * fq, pn = u.pn;
        float rs[2][4];
        { const PG8_LAS float* rp = rt + slot[u.pm] * BM + wr * 64 + fr;
#pragma unroll
          for (int ai = 0; ai < 2; ++ai)
#pragma unroll
              for (int m = 0; m < 4; ++m) rs[ai][m] = rp[ai * HALF + m * 16]; }
        if (pn == 46) {
            if (wc == 0 && fq < 2) {
#pragma unroll
                for (int ai = 0; ai < 2; ++ai)
#pragma unroll
                    for (int m = 0; m < 4; ++m) { float* gp = ga + (size_t)(row0 + ai * HALF + m * 16) * 16 + 8 * fq;
                        *(f32x4*)gp = acc[ai][0][m][0] * rs[ai][m]; *(f32x4*)(gp + 4) = acc[ai][0][m][1] * rs[ai][m]; }
            }
            return;
        }
        if (pn < 4) {
            const int ch0 = pn * HALF + wc * 32 + 8 * fq;
#pragma unroll
            for (int ai = 0; ai < 2; ++ai)
#pragma unroll
                for (int m = 0; m < 4; ++m) { const float r = rs[ai][m]; f32x4 a0 = acc[ai][0][m][0] * r, a1 = acc[ai][0][m][1] * r; const f32x4 g0 = acc[ai][1][m][0] * r, g1 = acc[ai][1][m][1] * r;
                    { a0 *= sigm4(g0); a1 *= sigm4(g1); }
                    u32x4 w; w.x = cvt_pk_bf16(a0[0], a0[1]); w.y = cvt_pk_bf16(a0[2], a0[3]); w.z = cvt_pk_bf16(a1[0], a1[1]); w.w = cvt_pk_bf16(a1[2], a1[3]);
                    *(u32x4*)(aglu + (size_t)(row0 + ai * HALF + m * 16) * 512 + ch0) = w; }
            return;
        }
        if (pn >= 10 && pn < 18) {
            const bool isk = pn >= 14;
#pragma unroll
            for (int ai = 0; ai < 2; ++ai)
#pragma unroll
                for (int m = 0; m < 4; ++m)
#pragma unroll
                    for (int bj = 0; bj < 2; ++bj) { const f32x4 a = acc[ai][bj][m][0], b = acc[ai][bj][m][1];
                        float s = ((a[0] * a[0] + a[1] * a[1]) + (a[2] * a[2] + a[3] * a[3])) + ((b[0] * b[0] + b[1] * b[1]) + (b[2] * b[2] + b[3] * b[3]));
                        s += __shfl_xor(s, 16); s += __shfl_xor(s, 32);
                        if (fq == 0) xl[(ai * HALF + wr * 64 + m * 16 + fr) * 8 + bj * 4 + wc] = s * (rs[ai][m] * rs[ai][m]); }
            asm volatile("s_waitcnt lgkmcnt(0)" ::: "memory"); __builtin_amdgcn_s_barrier(); asm volatile("" ::: "memory");
            const float* gp = (isk ? kg : qg) + wc * 32 + 8 * fq;
            const f32x4 gn0 = *(const f32x4*)gp, gn1 = *(const f32x4*)(gp + 4);
#pragma unroll
            for (int ai = 0; ai < 2; ++ai)
#pragma unroll
                for (int m = 0; m < 4; ++m) { const int rl = ai * HALF + wr * 64 + m * 16 + fr; const f32x4 p0 = *(const PG8_LAS f32x4*)(xl + rl * 8), p1 = *(const PG8_LAS f32x4*)(xl + rl * 8 + 4);
                    const float t0 = (p0[0] + p0[1]) + (p0[2] + p0[3]), t1 = (p1[0] + p1[1]) + (p1[2] + p1[3]);
                    const float r0 = __builtin_amdgcn_rsqf(t0 * (1.0f / 128.0f) + RMS_EPS) * rs[ai][m], r1 = __builtin_amdgcn_rsqf(t1 * (1.0f / 128.0f) + RMS_EPS) * rs[ai][m];
                    const int grow = row0 + ai * HALF + m * 16, bb = grow / seq, tt = grow - bb * seq;
                    bf16_t* rowp = qkv + ((size_t)((isk ? 1 : 0) * (2 * 8) + bb * 8 + 2 * (pn - (isk ? 14 : 10))) * seq + tt) * 128 + wc * 32 + 8 * fq;
#pragma unroll
                    for (int bj = 0; bj < 2; ++bj) { const float r = bj ? r1 : r0; const f32x4 v0 = acc[ai][bj][m][0] * r * gn0, v1 = acc[ai][bj][m][1] * r * gn1;
                        u32x4 w; w.x = cvt_pk_bf16(v0[0], v0[1]); w.y = cvt_pk_bf16(v0[2], v0[3]); w.z = cvt_pk_bf16(v1[0], v1[1]); w.w = cvt_pk_bf16(v1[2], v1[3]);
                        *(u32x4*)(rowp + (size_t)bj * seq * 128) = w; } }
            return;
        }
        if (pn >= 22) {
            unsigned char* g8 = (unsigned char*)Z + 580911104ll;
            f32x4 bv[2][2];
#pragma unroll
            for (int bj = 0; bj < 2; ++bj)
#pragma unroll
                for (int n = 0; n < 2; ++n) bv[bj][n] = *(const f32x4*)(bgate + (col0 - 22 * BM) + bj * HALF + 4 * n) * -1.4426950408889634f;
#pragma unroll
            for (int ai = 0; ai < 2; ++ai)
#pragma unroll
                for (int m = 0; m < 4; ++m) { const int grow = row0 + ai * HALF + m * 16; const float rn = rs[ai][m] * -1.4426950408889634f;
#pragma unroll
                    for (int bj = 0; bj < 2; ++bj) { const f32x4 v0 = sexp4s(acc[ai][bj][m][0] * rn + bv[bj][0], 1.0f / 255.0f), v1 = sexp4s(acc[ai][bj][m][1] * rn + bv[bj][1], 1.0f / 255.0f);
                        unsigned w0 = 0u, w1 = 0u;
                        w0 = __builtin_amdgcn_cvt_pk_u8_f32(v0[0], 0, w0); w0 = __builtin_amdgcn_cvt_pk_u8_f32(v0[1], 1, w0); w0 = __builtin_amdgcn_cvt_pk_u8_f32(v0[2], 2, w0); w0 = __builtin_amdgcn_cvt_pk_u8_f32(v0[3], 3, w0);
                        w1 = __builtin_amdgcn_cvt_pk_u8_f32(v1[0], 0, w1); w1 = __builtin_amdgcn_cvt_pk_u8_f32(v1[1], 1, w1); w1 = __builtin_amdgcn_cvt_pk_u8_f32(v1[2], 2, w1); w1 = __builtin_amdgcn_cvt_pk_u8_f32(v1[3], 3, w1);
                        typedef unsigned u32x2g __attribute__((ext_vector_type(2)));
                        *(u32x2g*)(g8 + (size_t)grow * 6144 + (col0 - 22 * BM) + bj * HALF) = (u32x2g){w0, w1}; } }
            return;
        }
        const bool sg = false;
        f32x4 bv[2][2];
#pragma unroll
        for (int bj = 0; bj < 2; ++bj)
#pragma unroll
            for (int n = 0; n < 2; ++n) bv[bj][n] = sg ? *(const f32x4*)(bgate + (col0 - 22 * BM) + bj * HALF + 4 * n) : (f32x4){0.f, 0.f, 0.f, 0.f};
#pragma unroll
        for (int ai = 0; ai < 2; ++ai)
#pragma unroll
            for (int m = 0; m < 4; ++m) { const int grow = row0 + ai * HALF + m * 16, bb = grow / seq, tt = grow - bb * seq; const bool isv = pn >= 18 && pn < 22;
                bf16_t* rowp = isv ? qkv + ((size_t)(2 * (2 * 8) + bb * 8 + 2 * (pn - 18)) * seq + tt) * 128 + wc * 32 + 8 * fq : Z + (size_t)grow * ldc + col0; const size_t bjs = isv ? (size_t)seq * 128 : (size_t)HALF; const float r = rs[ai][m];
#pragma unroll
                for (int bj = 0; bj < 2; ++bj) { f32x4 v0 = acc[ai][bj][m][0] * r + bv[bj][0], v1 = acc[ai][bj][m][1] * r + bv[bj][1];
                    if (sg) {
                        { v0 = sigm4(v0); v1 = sigm4(v1); } }
                    u32x4 w; w.x = cvt_pk_bf16(v0[0], v0[1]); w.y = cvt_pk_bf16(v0[2], v0[3]); w.z = cvt_pk_bf16(v1[0], v1[1]); w.w = cvt_pk_bf16(v1[2], v1[3]);
                    *(u32x4*)(rowp + bj * bjs) = w; } }
    }
};
template <int CTRL, bool BC> __device__ __forceinline__ float dppf(float old, float src) { return __builtin_bit_cast(float, __builtin_amdgcn_update_dpp(__builtin_bit_cast(int, old), __builtin_bit_cast(int, src), CTRL, 0xf, 0xf, BC)); }
__device__ __forceinline__ f32x4 prev_row1(const f32x4 xm, const f32x4 xm1) { f32x4 r;
#pragma unroll
    for (int j = 0; j < 4; ++j) r[j] = dppf<0x111, false>(dppf<0x10F, true>(0.f, xm1[j]), xm[j]);
    return r; }
__device__ __forceinline__ f32x4 prev_row2(const f32x4 xm, const f32x4 xm1) { f32x4 r;
#pragma unroll
    for (int j = 0; j < 4; ++j) r[j] = dppf<0x112, false>(dppf<0x10E, true>(0.f, xm1[j]), xm[j]);
    return r; }
struct EpiFfn {
    static constexpr bool PERM = true, AFTER_DRAIN = false, PERMA = true, SEGS = false;
    bf16_t* A; int ff; const float* fw; float* edge; const PG8_LAS float* rt; const PG8_LAS int* slot; PG8_LAS float* hx;
    __device__ __forceinline__ void operator()(const f32x4 (&acc)[2][2][4][2], const Unit& u, int wr, int wc, int fr, int fq) const {
        typedef unsigned u32x2 __attribute__((ext_vector_type(2)));
        const int rowg = u.pm * BM + wr * 64, ch0 = u.pn * HALF + wc * 32 + 8 * fq, colt = u.pn * BM + wc * 32 + 8 * fq, coll = wc * 32 + 8 * fq; const int ff2 = 2 * ff;
        float rs[2][4];
        { const PG8_LAS float* rp = rt + slot[u.pm] * BM + wr * 64 + 4 * fr;
#pragma unroll
          for (int ai = 0; ai < 2; ++ai)
#pragma unroll
              for (int m = 0; m < 4; ++m) rs[ai][m] = rp[ai * HALF + m]; }
        if (fr == 15) {
#pragma unroll
            for (int n = 0; n < 2; ++n)
#pragma unroll
                for (int ai = 0; ai < 2; ++ai) { const int g = ai * 2 + wr;
                    const f32x4 g2 = acc[ai][0][2][n] * rs[ai][2], g3 = acc[ai][0][3][n] * rs[ai][3], v2 = acc[ai][1][2][n] * rs[ai][2], v3 = acc[ai][1][3][n] * rs[ai][3];
                    if (g < 3) { PG8_LAS float* hp = hx + (g * 2) * 256 + coll + 4 * n;
                        *(PG8_LAS f32x4*)hp = g2; *(PG8_LAS f32x4*)(hp + 128) = v2; *(PG8_LAS f32x4*)(hp + 256) = g3; *(PG8_LAS f32x4*)(hp + 256 + 128) = v3; }
                    else { float* ep = edge + (size_t)(u.pm * 4 + 3) * 4 * ff2 + colt + 4 * n;
                        *(f32x4*)(ep) = g2; *(f32x4*)(ep + HALF) = v2; *(f32x4*)(ep + (size_t)ff2) = g3; *(f32x4*)(ep + (size_t)ff2 + HALF) = v3; } }
        }
        if (fr == 0 && wr == 0) {
#pragma unroll
            for (int n = 0; n < 2; ++n) { float* ep = edge + (size_t)(u.pm * 4) * 4 * ff2 + colt + 4 * n;
                *(f32x4*)(ep + (size_t)2 * ff2) = acc[0][0][0][n] * rs[0][0]; *(f32x4*)(ep + (size_t)2 * ff2 + HALF) = acc[0][1][0][n] * rs[0][0];
                *(f32x4*)(ep + (size_t)3 * ff2) = acc[0][0][1][n] * rs[0][1]; *(f32x4*)(ep + (size_t)3 * ff2 + HALF) = acc[0][1][1][n] * rs[0][1]; }
        }
        asm volatile("s_waitcnt lgkmcnt(0)" ::: "memory"); __builtin_amdgcn_s_barrier(); asm volatile("" ::: "memory");
        u32x2 w0s[2][4];
#pragma unroll
        for (int n = 0; n < 2; ++n) {
            f32x4 wg[3], wv[3];
#pragma unroll
            for (int j = 0; j < 3; ++j) { wg[j] = *(const f32x4*)(fw + (size_t)j * ff2 + ch0 + 4 * n); wv[j] = *(const f32x4*)(fw + (size_t)j * ff2 + ff + ch0 + 4 * n); }
#pragma unroll
            for (int ai = 0; ai < 2; ++ai) { const int g = ai * 2 + wr;
                f32x4 xg[4], xv[4];
#pragma unroll
                for (int m = 0; m < 4; ++m) { xg[m] = acc[ai][0][m][n] * rs[ai][m]; xv[m] = acc[ai][1][m][n] * rs[ai][m]; }
                f32x4 pg2, pg3, pv2, pv3;
#pragma unroll
                for (int j = 0; j < 4; ++j) { pg2[j] = dppf<0x111, true>(0.f, xg[2][j]); pg3[j] = dppf<0x111, true>(0.f, xg[3][j]); pv2[j] = dppf<0x111, true>(0.f, xv[2][j]); pv3[j] = dppf<0x111, true>(0.f, xv[3][j]); }
                if (fr == 0 && g > 0) { const PG8_LAS float* hp = hx + ((g - 1) * 2) * 256 + coll + 4 * n;
                    pg2 = *(const PG8_LAS f32x4*)hp; pv2 = *(const PG8_LAS f32x4*)(hp + 128); pg3 = *(const PG8_LAS f32x4*)(hp + 256); pv3 = *(const PG8_LAS f32x4*)(hp + 256 + 128); }
#pragma unroll
                for (int m = 0; m < 4; ++m) {
                    const f32x4 g2 = m >= 2 ? xg[m - 2] : (m == 1 ? pg3 : pg2), g1 = m >= 1 ? xg[m - 1] : pg3;
                    const f32x4 v2 = m >= 2 ? xv[m - 2] : (m == 1 ? pv3 : pv2), v1 = m >= 1 ? xv[m - 1] : pv3;
                    const f32x4 ug = wg[0] * g2 + wg[1] * g1 + wg[2] * xg[m];
                    const f32x4 uv = wv[0] * v2 + wv[1] * v1 + wv[2] * xv[m];
                    const f32x4 aw = ug * sigm4(ug) * uv; u32x2 w; w.x = cvt_pk_bf16(aw[0], aw[1]); w.y = cvt_pk_bf16(aw[2], aw[3]);
                    if (n == 0) w0s[ai][m] = w;
                    else if (m >= 2 || fr > 0 || g > 0) *(u32x4*)(A + (size_t)(rowg + ai * HALF + 4 * fr + m) * ff + ch0) = (u32x4){w0s[ai][m].x, w0s[ai][m].y, w.x, w.y}; }
            }
        }
    }
};
template <int MODE> struct EpiMerge {
    static constexpr bool PERM = true, AFTER_DRAIN = false, PERMA = false, SEGS = false;
    const bf16_t* G; int ldg, gcol0; bf16_t* tmp; bf16_t* mrg; int ldt;
    __device__ __forceinline__ void operator()(const f32x4 (&acc)[2][2][4][2], const Unit& u, int wr, int wc, int fr, int fq) const {
        const int row0 = u.pm * BM + wr * 64 + fr, col0 = u.pn * BM + wc * 32 + 8 * fq;
#pragma unroll
        for (int ai = 0; ai < 2; ++ai) {
            u32x4 gw[4][2], tw[4][2];
#pragma unroll
            for (int m = 0; m < 4; ++m)
#pragma unroll
                for (int bj = 0; bj < 2; ++bj) { const size_t row = (size_t)(row0 + ai * HALF + m * 16); const int col = col0 + bj * HALF;
                    gw[m][bj] = *(const u32x4*)(G + row * ldg + gcol0 + col); if (MODE >= 1) tw[m][bj] = *(const u32x4*)(tmp + row * ldt + col); }
#pragma unroll
            for (int m = 0; m < 4; ++m)
#pragma unroll
                for (int bj = 0; bj < 2; ++bj) { const size_t row = (size_t)(row0 + ai * HALF + m * 16); const int col = col0 + bj * HALF; const u32x4 g = gw[m][bj];
                    f32x4 v0 = acc[ai][bj][m][0] * (f32x4){bf_lo(g.x), bf_hi(g.x), bf_lo(g.y), bf_hi(g.y)};
                    f32x4 v1 = acc[ai][bj][m][1] * (f32x4){bf_lo(g.z), bf_hi(g.z), bf_lo(g.w), bf_hi(g.w)};
                    if (MODE >= 1) { const u32x4 t = tw[m][bj]; v0 += (f32x4){bf_lo(t.x), bf_hi(t.x), bf_lo(t.y), bf_hi(t.y)}; v1 += (f32x4){bf_lo(t.z), bf_hi(t.z), bf_lo(t.w), bf_hi(t.w)}; }
                    u32x4 w; w.x = cvt_pk_bf16(v0[0], v0[1]); w.y = cvt_pk_bf16(v0[2], v0[3]); w.z = cvt_pk_bf16(v1[0], v1[1]); w.w = cvt_pk_bf16(v1[2], v1[3]);
                    if (MODE <= 1) *(u32x4*)(tmp + row * ldt + col) = w; else *(u32x4*)(mrg + row * ldt + col) = w; }
        }
    }
};
struct EpiMerge3 {
    static constexpr bool PERM = true, AFTER_DRAIN = false, PERMA = false, SEGS = true; static constexpr int SEG1 = 8, SEG2 = 16;
    typedef unsigned u32x2q __attribute__((ext_vector_type(2)));
    const unsigned char* G; int ldg, gcol0; bf16_t* mrg; int ldt;
    static __device__ __forceinline__ f32x4 un4(const unsigned w) { return (f32x4){(float)(w & 255u), (float)((w >> 8) & 255u), (float)((w >> 16) & 255u), (float)(w >> 24)}; }
    static __device__ __forceinline__ f32x4 clamp4(f32x4 v) {
#pragma unroll
        for (int j = 0; j < 4; ++j) v[j] = fmaxf(v[j], 1e-9f);
        return v; }
    static __device__ __forceinline__ f32x4 rcp4(const f32x4 v) { f32x4 r;
#pragma unroll
        for (int j = 0; j < 4; ++j) r[j] = __builtin_amdgcn_rcpf(v[j]);
        return r; }
    __device__ __forceinline__ void rescale(f32x4 (&acc)[2][2][4][2], const Unit& u, int t, int wr, int wc, int fr, int fq) const {
        int row0 = u.pm * BM + wr * 64 + fr, col0 = u.pn * BM + wc * 32 + 8 * fq; const int bp = (t == SEG1) ? 0 : 1;
        asm volatile("" : "+v"(row0), "+v"(col0));
        const unsigned char* gb = G + (size_t)row0 * ldg + gcol0 + bp * 2048 + col0;
        u32x2q gp[2][4][2], gn[2][4][2];
#pragma unroll
        for (int ai = 0; ai < 2; ++ai)
#pragma unroll
            for (int m = 0; m < 4; ++m)
#pragma unroll
                for (int bj = 0; bj < 2; ++bj) { const unsigned char* p = gb + (size_t)(ai * HALF + m * 16) * ldg + bj * HALF; gp[ai][m][bj] = *(const u32x2q*)p; gn[ai][m][bj] = *(const u32x2q*)(p + 2048); }
#pragma unroll
        for (int ai = 0; ai < 2; ++ai)
#pragma unroll
            for (int m = 0; m < 4; ++m)
#pragma unroll
                for (int bj = 0; bj < 2; ++bj) {
                    acc[ai][bj][m][0] *= clamp4(un4(gp[ai][m][bj].x)) * rcp4(clamp4(un4(gn[ai][m][bj].x)));
                    acc[ai][bj][m][1] *= clamp4(un4(gp[ai][m][bj].y)) * rcp4(clamp4(un4(gn[ai][m][bj].y))); }
    }
    __device__ __forceinline__ void operator()(const f32x4 (&acc)[2][2][4][2], const Unit& u, int wr, int wc, int fr, int fq) const {
        const int row0 = u.pm * BM + wr * 64 + fr, col0 = u.pn * BM + wc * 32 + 8 * fq;
        u32x2q gw[2][4][2];
#pragma unroll
        for (int ai = 0; ai < 2; ++ai)
#pragma unroll
            for (int m = 0; m < 4; ++m)
#pragma unroll
                for (int bj = 0; bj < 2; ++bj) gw[ai][m][bj] = *(const u32x2q*)(G + (size_t)(row0 + ai * HALF + m * 16) * ldg + gcol0 + 2 * 2048 + col0 + bj * HALF);
#pragma unroll
        for (int ai = 0; ai < 2; ++ai)
#pragma unroll
            for (int m = 0; m < 4; ++m)
#pragma unroll
                for (int bj = 0; bj < 2; ++bj) { const f32x4 v0 = acc[ai][bj][m][0] * (clamp4(un4(gw[ai][m][bj].x)) * (1.0f / 255.0f)), v1 = acc[ai][bj][m][1] * (clamp4(un4(gw[ai][m][bj].y)) * (1.0f / 255.0f));
                    u32x4 w; w.x = cvt_pk_bf16(v0[0], v0[1]); w.y = cvt_pk_bf16(v0[2], v0[3]); w.z = cvt_pk_bf16(v1[0], v1[1]); w.w = cvt_pk_bf16(v1[2], v1[3]);
                    *(u32x4*)(mrg + (size_t)(row0 + ai * HALF + m * 16) * ldt + col0 + bj * HALF) = w; }
    }
};
template <bool PLE> struct EpiRes {
    static constexpr bool PERM = true, AFTER_DRAIN = false, PERMA = false, SEGS = false;
    const bf16_t* hi_in; bf16_t* hi_out; float* xout_f; float* rowss_out; const float* rowss_in; float inv_k; const bf16_t* pe; int ld;
    __device__ __forceinline__ void operator()(const f32x4 (&acc)[2][2][4][2], const Unit& u, int wr, int wc, int fr, int fq) const {
        const int row0 = u.pm * BM + wr * 64 + fr, col0 = u.pn * BM + wc * 32 + 8 * fq; constexpr int NB = PLE ? 2 : 4; constexpr bool PF = !PLE;
        float rs[2][4];
        if (PLE) { row_rstd4(rs[0], rowss_in, row0, fq, inv_k); row_rstd4(rs[1], rowss_in, row0 + HALF, fq, inv_k); }
        constexpr int NBT = 2 * (4 / NB);
        u32x4 xh[PF ? 2 : 1][NB][2], pw[PF ? 2 : 1][NB][2];
#define PG8_RES_LOAD(bi_, buf_) do { _Pragma("unroll") for (int mm = 0; mm < NB; ++mm) _Pragma("unroll") for (int bj = 0; bj < 2; ++bj) { \
            const size_t off = (size_t)(row0 + ((bi_) / (4 / NB)) * HALF + (NB * ((bi_) % (4 / NB)) + mm) * 16) * ld + col0 + bj * HALF; \
            xh[buf_][mm][bj] = *(const u32x4*)(hi_in + off); if (PLE) pw[buf_][mm][bj] = *(const u32x4*)(pe + off); } } while (0)
        if (PF) PG8_RES_LOAD(0, 0);
#pragma unroll
        for (int bi = 0; bi < NBT; ++bi) { const int ai = bi / (4 / NB), mh = bi % (4 / NB), buf = PF ? (bi & 1) : 0;
            if (PF) { if (bi + 1 < NBT) PG8_RES_LOAD(bi + 1, (bi + 1) & 1); } else PG8_RES_LOAD(bi, 0);
            __builtin_amdgcn_sched_barrier(0);
#pragma unroll
                for (int mm = 0; mm < NB; ++mm) { const int m = NB * mh + mm; const size_t row = (size_t)(row0 + ai * HALF + m * 16); float ss = 0.f;
                    const float r = PLE ? rs[ai][m] : 1.0f;
#pragma unroll
                    for (int bj = 0; bj < 2; ++bj) { const size_t off = row * ld + col0 + bj * HALF;
                        f32x4 v0 = acc[ai][bj][m][0], v1 = acc[ai][bj][m][1];
                        if (PLE) { const u32x4 p = pw[buf][mm][bj];
                            { v0 = sigm4(v0 * r); v1 = sigm4(v1 * r); }
                            v0 *= (f32x4){bf_lo(p.x), bf_hi(p.x), bf_lo(p.y), bf_hi(p.y)}; v1 *= (f32x4){bf_lo(p.z), bf_hi(p.z), bf_lo(p.w), bf_hi(p.w)}; }
                        const u32x4 h = xh[buf][mm][bj];
                        const f32x4 x0 = (f32x4){bf_lo(h.x), bf_hi(h.x), bf_lo(h.y), bf_hi(h.y)} + v0;
                        const f32x4 x1 = (f32x4){bf_lo(h.z), bf_hi(h.z), bf_lo(h.w), bf_hi(h.w)} + v1;
                        u32x4 w; w.x = cvt_pk_bf16(x0[0], x0[1]); w.y = cvt_pk_bf16(x0[2], x0[3]); w.z = cvt_pk_bf16(x1[0], x1[1]); w.w = cvt_pk_bf16(x1[2], x1[3]);
                        if (xout_f) { *(f32x4*)(xout_f + off) = x0; *(f32x4*)(xout_f + off + 4) = x1; }
                        else *(u32x4*)(hi_out + off) = w;
                        ss += (x0[0] * x0[0] + x0[1] * x0[1]) + (x0[2] * x0[2] + x0[3] * x0[3]) + (x1[0] * x1[0] + x1[1] * x1[1]) + (x1[2] * x1[2] + x1[3] * x1[3]); }
                    ss += __shfl_xor(ss, 16); ss += __shfl_xor(ss, 32);
                    if (fq == 0 && !xout_f) rowss_out[row * 32 + u.pn * 4 + wc] = ss; }
        }
#undef PG8_RES_LOAD
    }
};

struct NoPre { __device__ __forceinline__ void operator()() const {} };
template <class Epi, class Sched, bool ALIGN_EPI = false, bool SP2 = false, class Pre = NoPre>
__device__ __forceinline__ void gemm_phase(PG8_LAS unsigned char* lds, const Gemm g, const Sched& S, const Epi& E, Pre pre = Pre()) {
    int tid_ = threadIdx.x; asm volatile("" : "+v"(tid_));
    const int tid = tid_, wid = __builtin_amdgcn_readfirstlane(tid >> 6), lane = tid & 63, wr = wid >> 2, wc = wid & 3, fr = lane & 15, fq = lane >> 4;
    const int K = g.K, nt = K / BK;
    unsigned voffA[2], voffB[2];
#pragma unroll
    for (int i = 0; i < 2; ++i) { int R, C; stage_rc(tid * 16 + i * 8192, R, C); const int Rb = Epi::PERM ? ((R & ~31) + perm32(R & 31)) : R;
        const int Ra = Epi::PERMA ? ((R & ~63) + 4 * (R & 15) + ((R >> 4) & 3)) : R;
        voffA[i] = (unsigned)(Ra * K + C) * 2u; voffB[i] = (unsigned)(Rb * K + C) * 2u; }
    const size_t kstep = (size_t)(BK * 2);
    const size_t hstep = (size_t)HALF * K * 2;
    const size_t tstep = 2 * hstep;
    const unsigned ldsw = (unsigned)wid * 1024u;
    const int aoff = lds_byte(wr * 64 + fr, fq * 8), boff = lds_byte(wc * 32 + fr, fq * 8);
#define PG8_SA(b, h) (((b) * 2 + (h)) * HTB)
#define PG8_SB(b, h) ((4 + (b) * 2 + (h)) * HTB)
#define PG8_STAGE(bufoff, gbase, voff) do { _Pragma("unroll") for (int _i = 0; _i < 2; ++_i) \
        __builtin_amdgcn_global_load_lds((const unsigned*)((const char*)(gbase) + (voff)[_i]), (PG8_LAS unsigned*)(lds + (bufoff) + ldsw + _i * 8192), 16, 0, 0); } while (0)
#define PG8_LDA(dst, b, h) do { _Pragma("unroll") for (int m = 0; m < 4; ++m) _Pragma("unroll") for (int k = 0; k < 2; ++k) dst[m][k] = *(const PG8_LAS bf16x8*)(lds + PG8_SA(b, h) + aoff + m * 2048 + k * 1024); } while (0)
#define PG8_LDB(dst, b, h) do { _Pragma("unroll") for (int n = 0; n < 2; ++n) _Pragma("unroll") for (int k = 0; k < 2; ++k) dst[n][k] = *(const PG8_LAS bf16x8*)(lds + PG8_SB(b, h) + boff + n * 2048 + k * 1024); } while (0)
#define PG8_MMA(ai, bj, At, Bt) do { __builtin_amdgcn_s_setprio(1); _Pragma("unroll") for (int m = 0; m < 4; ++m) _Pragma("unroll") for (int n = 0; n < 2; ++n) _Pragma("unroll") for (int k = 0; k < 2; ++k) \
        acc[ai][bj][m][n] = __builtin_amdgcn_mfma_f32_16x16x32_bf16(Bt[n][k], At[m][k], acc[ai][bj][m][n], 0, 0, 0); __builtin_amdgcn_s_setprio(0); } while (0)
#define PG8_WAIT_V(n) asm volatile("s_waitcnt vmcnt(" #n ")" ::: "memory")
#define PG8_WAIT_L(n) asm volatile("s_waitcnt lgkmcnt(" #n ")" ::: "memory")
#define PG8_BAR __builtin_amdgcn_s_barrier()
#define PG8_SCHED __builtin_amdgcn_sched_barrier(0)
    Unit cur, nxt; int ui = 0;
    if (!S.next(0, cur)) return;
    bf16x8 At[4][2], B0[2][2], B1[2][2];
    const char* cA = (const char*)g.A + (size_t)cur.pm * tstep; const char* cB = (const char*)g.Bt + (size_t)cur.pn * tstep;
    S.a_ready(cur);
    if constexpr (SP2) {
        PG8_STAGE(PG8_SB(0, 0), cB, voffB); PG8_STAGE(PG8_SB(0, 1), cB + hstep, voffB); PG8_STAGE(PG8_SA(0, 0), cA, voffA); PG8_STAGE(PG8_SA(0, 1), cA + hstep, voffA);
        PG8_STAGE(PG8_SB(1, 0), cB + kstep, voffB); PG8_STAGE(PG8_SA(1, 0), cA + kstep, voffA); PG8_STAGE(PG8_SB(1, 1), cB + hstep + kstep, voffB);
        pre();
        if (wr == 1) PG8_BAR;
        PG8_WAIT_V(8); PG8_BAR;
        PG8_WAIT_V(6); PG8_BAR;
    } else {
        PG8_STAGE(PG8_SB(0, 0), cB, voffB); PG8_STAGE(PG8_SA(0, 0), cA, voffA); PG8_STAGE(PG8_SB(0, 1), cB + hstep, voffB); PG8_STAGE(PG8_SA(0, 1), cA + hstep, voffA);
        if (wr == 1) PG8_BAR;
        PG8_WAIT_V(4); PG8_BAR;
        PG8_STAGE(PG8_SB(1, 0), cB + kstep, voffB); PG8_STAGE(PG8_SA(1, 0), cA + kstep, voffA); PG8_STAGE(PG8_SB(1, 1), cB + hstep + kstep, voffB);
        PG8_WAIT_V(6); PG8_BAR;
    }
    f32x4 acc[2][2][4][2];
#pragma unroll
    for (int a = 0; a < 2; ++a)
#pragma unroll
        for (int b = 0; b < 2; ++b)
#pragma unroll
            for (int m = 0; m < 4; ++m)
#pragma unroll
                for (int n = 0; n < 2; ++n) acc[a][b][m][n] = (f32x4){0.f, 0.f, 0.f, 0.f};
    for (;;) {
        const bool has_next = S.next(ui + 1, nxt);
        const char* nA = has_next ? (const char*)g.A + (size_t)nxt.pm * tstep : cA + (size_t)(nt - 2) * kstep; const char* nB = has_next ? (const char*)g.Bt + (size_t)nxt.pn * tstep : cB + (size_t)(nt - 2) * kstep;
        for (int seg = 0; seg < (Epi::SEGS ? 3 : 1); ++seg) {
        int tb = 0, te = nt; if constexpr (Epi::SEGS) { tb = seg == 0 ? 0 : (seg == 1 ? Epi::SEG1 : Epi::SEG2); te = seg == 0 ? Epi::SEG1 : (seg == 1 ? Epi::SEG2 : nt); if (seg) E.rescale(acc, cur, tb, wr, wc, fr, fq); }
        for (int t = tb; t < te; t += 2) {
            const bool last = (t == nt - 2);
            const char* a1 = cA + (size_t)(t + 1) * kstep;
            const char* a2 = last ? nA : cA + (size_t)(t + 2) * kstep; const char* b2 = last ? nB : cB + (size_t)(t + 2) * kstep;
            const char* a3 = a2 + kstep; const char* b3 = b2 + kstep;
            if (last && has_next) S.a_ready(nxt);
            if constexpr (SP2) {
            PG8_LDB(B0, 0, 0); PG8_LDB(B1, 0, 1); PG8_SCHED; PG8_LDA(At, 0, 0); PG8_STAGE(PG8_SA(1, 1), a1 + hstep, voffA);
            PG8_WAIT_V(8); PG8_WAIT_L(0); PG8_BAR; PG8_MMA(0, 0, At, B0); PG8_MMA(0, 1, At, B1); PG8_BAR; PG8_SCHED;
            PG8_LDA(At, 0, 1); PG8_STAGE(PG8_SB(0, 0), b2, voffB); PG8_STAGE(PG8_SB(0, 1), b2 + hstep, voffB); PG8_STAGE(PG8_SA(0, 0), a2, voffA);
            PG8_WAIT_V(8); PG8_WAIT_L(0); PG8_BAR; PG8_MMA(1, 0, At, B0); PG8_MMA(1, 1, At, B1); PG8_BAR; PG8_SCHED;
            PG8_LDB(B0, 1, 0); PG8_LDB(B1, 1, 1); PG8_SCHED; PG8_LDA(At, 1, 0); PG8_STAGE(PG8_SA(0, 1), a2 + hstep, voffA);
            PG8_WAIT_V(8); PG8_WAIT_L(0); PG8_BAR; PG8_MMA(0, 0, At, B0); PG8_MMA(0, 1, At, B1); PG8_BAR; PG8_SCHED;
            PG8_LDA(At, 1, 1); PG8_STAGE(PG8_SB(1, 0), b3, voffB); PG8_STAGE(PG8_SB(1, 1), b3 + hstep, voffB); PG8_STAGE(PG8_SA(1, 0), a3, voffA);
            PG8_WAIT_V(8); PG8_WAIT_L(0); PG8_BAR; PG8_MMA(1, 0, At, B0); PG8_MMA(1, 1, At, B1); PG8_BAR; PG8_SCHED;
            } else {
            PG8_LDB(B0, 0, 0); PG8_SCHED; PG8_LDA(At, 0, 0); PG8_STAGE(PG8_SA(1, 1), a1 + hstep, voffA);
            PG8_WAIT_L(8); PG8_BAR; PG8_WAIT_L(0); PG8_MMA(0, 0, At, B0); PG8_BAR; PG8_SCHED;
            PG8_LDB(B1, 0, 1); PG8_STAGE(PG8_SB(0, 0), b2, voffB);
            PG8_BAR; PG8_WAIT_L(0); PG8_MMA(0, 1, At, B1); PG8_BAR;
            PG8_LDA(At, 0, 1); PG8_STAGE(PG8_SA(0, 0), a2, voffA);
            PG8_BAR; PG8_WAIT_L(0); PG8_MMA(1, 0, At, B0); PG8_BAR; PG8_SCHED;
            PG8_STAGE(PG8_SB(0, 1), b2 + hstep, voffB);
            PG8_WAIT_V(6); PG8_BAR; PG8_MMA(1, 1, At, B1); PG8_BAR;
            PG8_LDB(B0, 1, 0); PG8_SCHED; PG8_LDA(At, 1, 0); PG8_STAGE(PG8_SA(0, 1), a2 + hstep, voffA);
            PG8_WAIT_L(8); PG8_BAR; PG8_WAIT_L(0); PG8_MMA(0, 0, At, B0); PG8_BAR; PG8_SCHED;
            PG8_LDB(B1, 1, 1); PG8_STAGE(PG8_SB(1, 0), b3, voffB);
            PG8_BAR; PG8_WAIT_L(0); PG8_MMA(0, 1, At, B1); PG8_BAR;
            PG8_LDA(At, 1, 1); PG8_STAGE(PG8_SA(1, 0), a3, voffA);
            PG8_BAR; PG8_WAIT_L(0); PG8_MMA(1, 0, At, B0); PG8_BAR; PG8_SCHED;
            PG8_STAGE(PG8_SB(1, 1), b3 + hstep, voffB);
            PG8_WAIT_V(6); PG8_BAR; PG8_MMA(1, 1, At, B1); PG8_BAR;
            }
        }
        }
        if constexpr (ALIGN_EPI) { if (wr == 0) PG8_BAR; }
        if constexpr (!Epi::AFTER_DRAIN) { E(acc, cur, wr, wc, fr, fq); S.done(cur); }
        if (!has_next) break;
#pragma unroll
        for (int a = 0; a < 2; ++a)
#pragma unroll
            for (int b = 0; b < 2; ++b)
#pragma unroll
                for (int m = 0; m < 4; ++m)
#pragma unroll
                    for (int n = 0; n < 2; ++n) acc[a][b][m][n] = (f32x4){0.f, 0.f, 0.f, 0.f};
        cur = nxt; cA = nA; cB = nB; ++ui;
        if constexpr (ALIGN_EPI) { if (wr == 1) PG8_BAR; }
    }
    PG8_WAIT_V(0);
    if constexpr (!ALIGN_EPI) { if (wr == 0) PG8_BAR; }
    PG8_BAR;
    if constexpr (Epi::AFTER_DRAIN) { E.fused(acc, cur, wr, wc, fr, fq, lds, wid, lane); S.done(cur); }
#undef PG8_SA
#undef PG8_SB
#undef PG8_STAGE
#undef PG8_LDA
#undef PG8_LDB
#undef PG8_MMA
#undef PG8_WAIT_V
#undef PG8_WAIT_L
#undef PG8_BAR
#undef PG8_SCHED
}
}
namespace moba {
typedef unsigned short bf16;
typedef short bf16x8 __attribute__((ext_vector_type(8)));
typedef short s16x4 __attribute__((ext_vector_type(4)));
typedef float f32x16 __attribute__((ext_vector_type(16)));
typedef float f32x4 __attribute__((ext_vector_type(4)));
typedef unsigned u32x4 __attribute__((ext_vector_type(4)));
constexpr int D = 128, NW = 8, QBLK = 32, KVBLK = 64, QB = NW * QBLK;
constexpr int SHM_V = KVBLK * D * 2, SHM_K = KVBLK * D * 2;
constexpr int LDS_BYTES = 2 * SHM_V + 2 * SHM_K + NW * 64 * 4;
constexpr float SCALE = 0.08838834764831845f, THR = 8.f;
constexpr int KMH = 2 * 8 * 16 * 128;
#define KSWZ(row, colB) ((row) * 256 + ((colB) ^ (((row) & 7) << 4)))
#define SBAR() __builtin_amdgcn_sched_barrier(0)
__device__ __forceinline__ int v_st(int k, int c) { const int kk = (k & ~0xC) | ((k & 4) << 1) | ((k & 8) >> 1); return ((kk >> 3) * 4 + (c >> 5)) * 512 + ((kk & 7) * 32 + (c & 31)) * 2; }
__device__ __forceinline__ int v_rd_base(int lane) { return ((lane & 3) << 3) | (((lane >> 2) & 3) << 6) | (((lane >> 4) & 1) << 5) | (((lane >> 5) & 1) << 8); }
constexpr int v_rd_off(int d0, int ks, int half) { return d0 * 512 + ks * 4096 + half * 2048; }
__device__ __forceinline__ int crow(int r, int hi) { return (r & 3) + 8 * (r >> 2) + 4 * hi; }
__device__ __forceinline__ unsigned cvtpk(float lo, float hi) { unsigned r; asm volatile("v_cvt_pk_bf16_f32 %0, %1, %2" : "=v"(r) : "v"(lo), "v"(hi)); return r; }
__device__ __forceinline__ bf16x8 pack8(f32x4 a, f32x4 b) { u32x4 w = {cvtpk(a[0], a[1]), cvtpk(a[2], a[3]), cvtpk(b[0], b[1]), cvtpk(b[2], b[3])}; return *reinterpret_cast<bf16x8*>(&w); }
__device__ __forceinline__ bf16x8 load8(const bf16* p) { return *reinterpret_cast<const bf16x8*>(p); }
__device__ __forceinline__ void mask_tile(f32x16& p0, f32x16& p1, int dq) {
    const float NEG = -__builtin_inff();
#pragma unroll
    for (int r = 0; r < 16; ++r) { const int c = (r & 3) + 8 * (r >> 2); if (dq - c < 0) p0[r] = NEG; if (dq - c - 32 < 0) p1[r] = NEG; }
}
__device__ __forceinline__ void mask_all(f32x16& p0, f32x16& p1, bool keep) {
    const float NEG = -__builtin_inff();
#pragma unroll
    for (int r = 0; r < 16; ++r) { p0[r] = keep ? p0[r] : NEG; p1[r] = keep ? p1[r] : NEG; }
}
__device__ __forceinline__ void partialSM(f32x16& p0, f32x16& p1, float& m_reg, float& mn, float& alpha, bool keep) {
    float pmax = p0[0]; for (int r = 1; r < 16; ++r) pmax = fmaxf(pmax, p0[r]); for (int r = 0; r < 16; ++r) pmax = fmaxf(pmax, p1[r]);
    pmax = keep ? pmax : -__builtin_inff();
    { auto rr = __builtin_amdgcn_permlane32_swap(__float_as_uint(pmax), __float_as_uint(pmax), false, false);
      pmax = fmaxf(__uint_as_float(rr[0]), __uint_as_float(rr[1])); }
    constexpr float C2 = 1.4426950408889634f * SCALE;
    if (__builtin_expect(__all((pmax - m_reg) * SCALE <= THR), 1)) { mn = m_reg; alpha = 1.f; }
    else { mn = fmaxf(m_reg, pmax); alpha = __builtin_amdgcn_exp2f((m_reg - mn) * C2); m_reg = mn; }
    const float mnL = keep ? -mn * C2 : -__builtin_inff();
    p0 = p0 * C2 + mnL; p1 = p1 * C2 + mnL;
    for (int r = 0; r < 16; ++r) p0[r] = __builtin_amdgcn_exp2f(p0[r]);
}
__device__ __forceinline__ void finishSM(f32x16& p0, f32x16& p1, float alpha, float& l_reg, bf16x8& pa0, bf16x8& pa1, bf16x8& pa2, bf16x8& pa3) {
    for (int r = 0; r < 16; ++r) p1[r] = __builtin_amdgcn_exp2f(p1[r]);
    float ps;
    { typedef float f32x8_ __attribute__((ext_vector_type(8))); typedef float f32x4_ __attribute__((ext_vector_type(4))); typedef float f32x2_ __attribute__((ext_vector_type(2)));
      const f32x16 s16 = p0 + p1; const f32x8_ s8 = s16.lo + s16.hi; const f32x4_ s4 = s8.lo + s8.hi; const f32x2_ s2 = s4.lo + s4.hi; ps = s2.x + s2.y; }
    { auto rr = __builtin_amdgcn_permlane32_swap(__float_as_uint(ps), __float_as_uint(ps), false, false);
      ps = __uint_as_float(rr[0]) + __uint_as_float(rr[1]); }
    l_reg = l_reg * alpha + ps;
#define PK4(P, B_, OUT) do { unsigned a0 = cvtpk(P[B_+0], P[B_+1]), a1 = cvtpk(P[B_+2], P[B_+3]);                          \
        unsigned b0 = cvtpk(P[B_+4], P[B_+5]), b1 = cvtpk(P[B_+6], P[B_+7]);                                             \
        auto r0 = __builtin_amdgcn_permlane32_swap(a0, b0, false, false); auto r1 = __builtin_amdgcn_permlane32_swap(a1, b1, false, false); \
        u32x4 w = {r0[0], r1[0], r0[1], r1[1]}; OUT = *reinterpret_cast<bf16x8*>(&w); } while (0)
    PK4(p0, 0, pa0); PK4(p0, 8, pa1); PK4(p1, 0, pa2); PK4(p1, 8, pa3);
#undef PK4
}
template <int KB>
__device__ __forceinline__ void qkt(f32x16& p0, f32x16& p1, const char* K_lds, int r32, int hi, const bf16x8* qr) {
    p0 = f32x16{}; p1 = f32x16{};
    const char* kb[4];
#pragma unroll
    for (int dd = 0; dd < 4; ++dd) kb[dd] = K_lds + KB * SHM_K + KSWZ(r32, (dd * 16 + hi * 8) * 2);
#pragma unroll
    for (int d0 = 0; d0 < 8; ++d0) { const char* a = kb[d0 & 3] + (d0 >> 2) * 128;
        bf16x8 b0 = *reinterpret_cast<const bf16x8*>(a);
        bf16x8 b1 = *reinterpret_cast<const bf16x8*>(a + 32 * 256);
        p0 = __builtin_amdgcn_mfma_f32_32x32x16_bf16(b0, qr[d0], p0, 0, 0, 0);
        p1 = __builtin_amdgcn_mfma_f32_32x32x16_bf16(b1, qr[d0], p1, 0, 0, 0); }
}
template <int VB>
__device__ __forceinline__ void pv_tile(f32x16* o, int vb0, bf16x8 pa0, bf16x8 pa1, bf16x8 pa2, bf16x8 pa3) {
#define TRRD(dst, off) asm volatile("ds_read_b64_tr_b16 %0, %1 offset:%2" : "=&v"(dst) : "v"(vb0), "i"(off) : "memory")
#define PV_D0(d0) do { s16x4 l0, l1, l2, l3, h0, h1, h2, h3; constexpr int b_ = VB * SHM_V + v_rd_off(d0, 0, 0); \
        TRRD(l0, b_); TRRD(h0, b_ + 2048); TRRD(l1, b_ + 4096); TRRD(h1, b_ + 6144); TRRD(l2, b_ + 8192); TRRD(h2, b_ + 10240); TRRD(l3, b_ + 12288); TRRD(h3, b_ + 14336); \
        asm volatile("s_waitcnt lgkmcnt(0)" ::: "memory"); SBAR();   \
        o[d0] = __builtin_amdgcn_mfma_f32_32x32x16_bf16(pa0, (bf16x8){l0[0], l0[1], l0[2], l0[3], h0[0], h0[1], h0[2], h0[3]}, o[d0], 0, 0, 0);   \
        o[d0] = __builtin_amdgcn_mfma_f32_32x32x16_bf16(pa1, (bf16x8){l1[0], l1[1], l1[2], l1[3], h1[0], h1[1], h1[2], h1[3]}, o[d0], 0, 0, 0);   \
        o[d0] = __builtin_amdgcn_mfma_f32_32x32x16_bf16(pa2, (bf16x8){l2[0], l2[1], l2[2], l2[3], h2[0], h2[1], h2[2], h2[3]}, o[d0], 0, 0, 0);   \
        o[d0] = __builtin_amdgcn_mfma_f32_32x32x16_bf16(pa3, (bf16x8){l3[0], l3[1], l3[2], l3[3], h3[0], h3[1], h3[2], h3[3]}, o[d0], 0, 0, 0); } while (0)
    PV_D0(0); PV_D0(1); PV_D0(2); PV_D0(3);
#undef PV_D0
#undef TRRD
}
struct BlockRef { const bf16* Q; const bf16* K; const bf16* V; bf16* O; const float* KM; float* ML; int j, tlo, thi; };
struct Seam { bf16x8 qr[8]; bf16x8 st_v0, st_v1, st_k0, st_k1; };
#define ROW(p, k0, rr) ((p) + (size_t)((k0) + (rr)) * PIN + sc)
#define VMW() asm volatile("s_waitcnt vmcnt(0)" ::: "memory")
#define VMWN(n) asm volatile("s_waitcnt vmcnt(%0)" :: "i"(n) : "memory")
#define SLOAD_H(Kp, Vp, k0) do { S.st_v0 = load8(ROW(Vp, k0, sr)); S.st_v1 = load8(ROW(Vp, k0, 32 + sr));              \
                         S.st_k0 = load8(ROW(Kp, k0, sr)); S.st_k1 = load8(ROW(Kp, k0, 32 + sr)); } while (0)
#define SWRITE_HK(bf) do { *(bf16x8*)(K_lds + (bf) * SHM_K + kws) = S.st_k0; *(bf16x8*)(K_lds + (bf) * SHM_K + kws + 32 * 256) = S.st_k1; } while (0)
#define SWRITE_HV(bf) do { *(bf16x8*)(V_lds + (bf) * SHM_V + vst0) = S.st_v0; *(bf16x8*)(V_lds + (bf) * SHM_V + vst1) = S.st_v1; } while (0)
#define SWRITE_H(bf) do { SWRITE_HV(bf); SWRITE_HK(bf); } while (0)
template <int PIN, class Between>
__device__ __forceinline__ void moba_prime(const BlockRef& cur, char* lds, Seam& S, Between&& between) {
    int tid_ = threadIdx.x; asm volatile("" : "+v"(tid_));
    const int tid = tid_, wid = __builtin_amdgcn_readfirstlane(tid >> 6), lane = tid & 63, r32 = lane & 31, hi = lane >> 5;
    const int sr = tid >> 4, sc = (tid & 15) * 8, kws = KSWZ(sr, sc * 2); char* K_lds = lds + 2 * SHM_V;
    for (int d0 = 0; d0 < 8; ++d0) S.qr[d0] = load8(cur.Q + (size_t)(wid * QBLK + r32) * PIN + d0 * 16 + hi * 8);
    SLOAD_H(cur.K, cur.V, cur.tlo * KVBLK); between(); VMW(); SWRITE_HK(0);
    __syncthreads();
}
template <int PIN, int PO>
__device__ __forceinline__ void moba_block(const BlockRef& cur, const BlockRef& nxt, char* lds, Seam& S) {
    int tid_ = threadIdx.x; asm volatile("" : "+v"(tid_));
    const int tid = tid_, wid = __builtin_amdgcn_readfirstlane(tid >> 6), lane = tid & 63, r32 = lane & 31, hi = lane >> 5;
    const int jb = cur.j, P0 = jb * QB;
    const int NT = cur.thi - cur.tlo, TB = cur.tlo;
    const int qlo = P0 + wid * QBLK, qm = qlo + r32 - 4 * hi;
    char* V_lds = lds; char* K_lds = lds + 2 * SHM_V;
    float* ws = (float*)(lds + 2 * SHM_V + 2 * SHM_K) + wid * 64; float* li_l = ws, * al_l = ws + 32;
    float m_reg = -1e30f, l_reg = 0; f32x16 o[4] = {};
    const int sr = tid >> 4, sc = (tid & 15) * 8, vst0 = v_st(sr, sc), vst1 = v_st(32 + sr, sc), kws = KSWZ(sr, sc * 2);
    const int vb0 = (int)(uintptr_t)V_lds + v_rd_base(lane);
    const bf16* Kh = cur.K; const bf16* Vh = cur.V;
    unsigned selmask = 0u;
    if (jb > 0) {
        f32x16 sc16 = f32x16{};
#pragma unroll
        for (int d0 = 0; d0 < 8; ++d0) { bf16x8 a = (bf16x8){0, 0, 0, 0, 0, 0, 0, 0};
            if (r32 < 16) { const float* kp = cur.KM + r32 * D + d0 * 16 + hi * 8; a = pack8(*(const f32x4*)kp, *(const f32x4*)(kp + 4)); }
            sc16 = __builtin_amdgcn_mfma_f32_32x32x16_bf16(a, S.qr[d0], sc16, 0, 0, 0); }
        float s16[16];
#pragma unroll
        for (int r = 0; r < 8; ++r) { auto rr = __builtin_amdgcn_permlane32_swap(__float_as_uint(sc16[r]), __float_as_uint(sc16[r]), false, false);
            s16[(r & 3) + 8 * (r >> 2)] = __uint_as_float(rr[0]); s16[(r & 3) + 8 * (r >> 2) + 4] = __uint_as_float(rr[1]); }
        const float NEGI = -__builtin_inff();
#pragma unroll
        for (int n = 0; n < 16; ++n) s16[n] = (n < jb) ? s16[n] : NEGI;
#pragma unroll
        for (int it = 0; it < 3; ++it) { float best = NEGI; int bi = 16;
#pragma unroll
            for (int n = 0; n < 16; ++n) { if (s16[n] > best) { best = s16[n]; bi = n; } }
            selmask |= (bi < 16) ? (1u << bi) : 0u;
#pragma unroll
            for (int n = 0; n < 16; ++n) s16[n] = (n == bi) ? NEGI : s16[n]; }
    }
#define RESC(a) do { if (__any((a) < 1.f)) { if (hi == 0) al_l[r32] = (a); asm volatile("s_waitcnt lgkmcnt(0)" ::: "memory");              \
                     for (int d_ = 0; d_ < 4; ++d_) for (int r = 0; r < 16; ++r) o[d_][r] *= al_l[crow(r, hi)]; } } while (0)
#define KBASE(t) ((TB + (t)) * KVBLK)
#define MASKT(P0_, P1_, t) do { const int kb_ = KBASE(t); const int nb_ = (TB + (t)) >> 2; keep_ = true; \
        if (nb_ < jb) { keep_ = ((selmask >> nb_) & 1u) != 0u; } \
        else if (kb_ + KVBLK - 1 > qlo) { mask_tile(P0_, P1_, qm - kb_); } } while (0)
    constexpr int NQL = 8;
#define SEAM_K0() do { VMWN(NQL); SWRITE_HK(0); SBAR(); } while (0)
    f32x16 pA0, pA1, pB0, pB1; float mnA, mnB, alA, alB; bf16x8 pa0, pa1, pa2, pa3; bool keep_ = true;
    SWRITE_HV(0); SBAR();
    if (NT > 1) { SLOAD_H(Kh, Vh, KBASE(1)); }
    SBAR(); qkt<0>(pA0, pA1, K_lds, r32, hi, S.qr);
    MASKT(pA0, pA1, 0); partialSM(pA0, pA1, m_reg, mnA, alA, keep_);
    if (NT > 1) { VMW(); SWRITE_H(1); }
    __syncthreads();
#define HALF_STEP(PX0, PX1, mnX, alX, PY0, PY1, alY, t, KB, VB, SB) do {                                                      \
        SBAR(); qkt<KB>(PX0, PX1, K_lds, r32, hi, S.qr);                                             \
        finishSM(PY0, PY1, alY, l_reg, pa0, pa1, pa2, pa3); SBAR();                                                           \
        if ((t) + 1 < NT) { SLOAD_H(Kh, Vh, KBASE((t) + 1)); SBAR(); }                                               \
        pv_tile<VB>(o, vb0, pa0, pa1, pa2, pa3); MASKX(PX0, PX1, (t)); partialSM(PX0, PX1, m_reg, mnX, alX, keep_);                                        \
        __syncthreads();                                                                                                      \
        if ((t) + 1 < NT) { VMW(); SWRITE_H(SB); }                                                                          \
        RESC(alX); __syncthreads(); } while (0)
    const int tpast = 4 * jb - TB;
    int t = 1;
#define MASKX(P0_, P1_, t_) do { keep_ = ((selmask >> ((TB + (t_)) >> 2)) & 1u) != 0u; } while (0)
    for (; t + 1 < NT && t + 1 < tpast; t += 2) {
        HALF_STEP(pB0, pB1, mnB, alB, pA0, pA1, alA, t, 1, 0, 0);
        HALF_STEP(pA0, pA1, mnA, alA, pB0, pB1, alB, t + 1, 0, 1, 1);
    }
#undef MASKX
#define MASKX(P0_, P1_, t_) MASKT(P0_, P1_, t_)
    for (; t + 1 < NT; t += 2) {
        HALF_STEP(pB0, pB1, mnB, alB, pA0, pA1, alA, t, 1, 0, 0);
        HALF_STEP(pA0, pA1, mnA, alA, pB0, pB1, alB, t + 1, 0, 1, 1);
    }
#undef MASKX
    const bool even = (NT & 1) == 0;
    if (even) { SBAR(); qkt<1>(pB0, pB1, K_lds, r32, hi, S.qr); SBAR(); }
    SLOAD_H(nxt.K, nxt.V, nxt.tlo * KVBLK); SBAR();
#pragma unroll
    for (int d0 = 0; d0 < 8; ++d0) S.qr[d0] = load8(nxt.Q + (size_t)(wid * QBLK + r32) * PIN + d0 * 16 + hi * 8);
    SBAR();
    finishSM(pA0, pA1, alA, l_reg, pa0, pa1, pa2, pa3); SBAR();
    pv_tile<0>(o, vb0, pa0, pa1, pa2, pa3);
    if (even) { MASKT(pB0, pB1, NT - 1); partialSM(pB0, pB1, m_reg, mnB, alB, keep_); __syncthreads(); RESC(alB);
        finishSM(pB0, pB1, alB, l_reg, pa0, pa1, pa2, pa3); SBAR(); pv_tile<1>(o, vb0, pa0, pa1, pa2, pa3); }
    SBAR(); SEAM_K0();
    if (hi == 0) li_l[r32] = l_reg; asm volatile("s_waitcnt lgkmcnt(0)" ::: "memory");
    float rli[16];
#pragma unroll
    for (int r = 0; r < 16; ++r) { const float lv = li_l[crow(r, hi)]; rli[r] = lv > 0.f ? __builtin_amdgcn_rcpf(lv) : 0.f; }
    if (hi == 0) { typedef float f32x2 __attribute__((ext_vector_type(2))); *(f32x2*)(cur.ML + (size_t)(wid * QBLK + r32) * 16) = (f32x2){m_reg, l_reg}; }
    bf16* Ow = cur.O + (size_t)(wid * QBLK) * PO;
#pragma unroll
    for (int r = 0; r < 16; ++r) { const int orow = crow(r, hi);
#pragma unroll
        for (int d0 = 0; d0 < 4; ++d0) { const float v = o[d0][r] * rli[r];
            const float vn = __shfl_xor(v, 1);
            if ((r32 & 1) == 0) *(unsigned*)(Ow + (size_t)orow * PO + d0 * 32 + r32) = cvtpk(v, vn); } }
    __syncthreads();
#undef RESC
#undef KBASE
#undef MASKT
#undef SEAM_K0
#undef HALF_STEP
}
#undef ROW
#undef VMW
#undef VMWN
#undef SLOAD_H
#undef SWRITE_HK
#undef SWRITE_HV
#undef SWRITE_H
#undef KSWZ
#undef SBAR
}

constexpr int NWAVES = 8, NTHR = 512; constexpr float RMS_EPS = 1e-6f;
constexpr int BATCH = 2, SEQ = 4096, T = BATCH * SEQ, DM = 2048, DEPTH = 4, PLE = 256;
constexpr int CCH = 512, CWID = 31;
constexpr int GH = 4, GDK = 64, GDV = 128, GRANK = 16, GCH = 64, GNC = SEQ / GCH;
constexpr int MH = 8, MHD = 128, MBLK = 256, MNB = SEQ / MBLK;
constexpr int FF = 5632, FF2 = 2 * FF, IN_COLS = 5648, NGATE = 3 * DM;
constexpr int ZN = 47 * 256;
constexpr int ZC_GLU = 0, ZC_GQ = 1024, ZC_GK = 1280, ZC_GV = 1536, ZC_GR = 2048, ZC_MQ = 2560, ZC_MK = 3584, ZC_MV = 4608, ZC_GATE = 5632, ZC_GA = 11776;
constexpr size_t MiB = 1u << 20;
constexpr size_t WS_CTL = 0, CTL_ZERO_BYTES = 32 * 1024;
constexpr int CW_TMO = 0, CW_BAR = 4096;
constexpr size_t WS_ROWSS = 1 * MiB;
constexpr size_t WS_W = 4 * MiB;
constexpr size_t WO_W1 = 0, WO_CA = WO_W1 + (size_t)ZN * DM * 2, WO_GL = WO_CA + (size_t)DM * CCH * 2, WO_MO = WO_GL + (size_t)DM * 512 * 2, WO_OU = WO_MO + (size_t)DM * 1024 * 2,
                 WO_UP = WO_OU + (size_t)DM * DM * 2, WO_DN = WO_UP + (size_t)FF2 * DM * 2, WO_PG = WO_DN + (size_t)DM * FF * 2, WO_PL = WO_PG + (size_t)DM * DM * 2, W_LAYER = WO_PL + (size_t)DM * PLE * 2;
static_assert(W_LAYER == 138 * MiB, "weight bytes per layer");
constexpr size_t WS_ACT = WS_W + DEPTH * W_LAYER;
constexpr size_t WS_XBA = WS_ACT, WS_XBB = WS_XBA + 32 * MiB, WS_XBC = WS_XBB + 32 * MiB, WS_ZB = WS_XBC + 32 * MiB;
constexpr size_t WS_TMP = WS_ZB + 188 * MiB, WS_MRG = WS_TMP + 64 * MiB;
constexpr size_t WS_ACONV = WS_MRG + 32 * MiB, WS_OMOBA = WS_ACONV + 8 * MiB, WS_GQT = WS_OMOBA + 16 * MiB, WS_GINTRA = WS_GQT + 4 * MiB, WS_GDELTA = WS_GINTRA + 16 * MiB,
                 WS_GST = WS_GDELTA + 16 * MiB, WS_GDEC = WS_GST + 8 * MiB, WS_OGLA = WS_GDEC + 1 * MiB, WS_GA = WS_OGLA + 8 * MiB, WS_KMEAN = WS_GA + 1 * MiB, WS_PB = WS_KMEAN + 1 * MiB,
                 WS_PE = WS_PB + 16 * MiB, WS_RSP = WS_PE + 32 * MiB, WS_OP1 = WS_RSP + 13 * MiB, WS_ML = WS_OP1 + 16 * MiB, WS_EDGE = WS_ML + 2 * MiB, WS_AGLU = WS_EDGE + 24 * MiB, WS_QKV = WS_AGLU + 8 * MiB, WS_ACAT = WS_QKV + 48 * MiB, WS_G8 = WS_ACAT + 32 * MiB, WS_END = WS_G8 + 48 * MiB;
static_assert((size_t)T * ZN * 2 <= 188 * MiB && (size_t)T * FF2 * 2 <= 188 * MiB && (size_t)T * FF * 2 <= 96 * MiB, "overlays");
constexpr int RING_OFF = 0, RING_BYTES = 131072, LDSCTL_OFF = RING_BYTES, MISC_OFF = LDSCTL_OFF + 320, XL_OFF = LDSCTL_OFF + 2048  , RT_OFF = LDSCTL_OFF + 10240  , SLOT_OFF = LDSCTL_OFF + 1280  , LDS_BYTES = 147456;

#define GAS __attribute__((address_space(1)))
#define LAS __attribute__((address_space(3)))
typedef unsigned short bf16;
typedef unsigned v4u __attribute__((ext_vector_type(4)));
typedef float f32x4 __attribute__((ext_vector_type(4)));
typedef short bf16x8 __attribute__((ext_vector_type(8)));
typedef GAS unsigned gu32;
#define RLX_AGENT __ATOMIC_RELAXED, __HIP_MEMORY_SCOPE_AGENT
#define LDS_WAIT() asm volatile("s_waitcnt lgkmcnt(0)" ::: "memory")
#define VM_WAIT() asm volatile("s_waitcnt vmcnt(0)" ::: "memory")
__device__ __forceinline__ unsigned f2bf(float f) { unsigned u = __builtin_bit_cast(unsigned, f); return (u + 0x7fffu + ((u >> 16) & 1u)) >> 16; }
__device__ __forceinline__ unsigned pk2(float lo, float hi) { return f2bf(lo) | (f2bf(hi) << 16); }
__device__ __forceinline__ float bflo(unsigned w) { return __uint_as_float(w << 16); }
__device__ __forceinline__ float bfhi(unsigned w) { return __uint_as_float(w & 0xffff0000u); }
__device__ __forceinline__ float sigm(float v) { return __builtin_amdgcn_rcpf(1.0f + __builtin_amdgcn_exp2f(-1.4426950408889634f * v)); }
__device__ __forceinline__ float wave_sum(float v) {
#pragma unroll
    for (int o = 1; o < 64; o <<= 1) v += __shfl_xor(v, o);
    return v;
}
__device__ __forceinline__ void unpack8(const v4u w, float (&f)[8]) { f[0] = bflo(w.x); f[1] = bfhi(w.x); f[2] = bflo(w.y); f[3] = bfhi(w.y); f[4] = bflo(w.z); f[5] = bfhi(w.z); f[6] = bflo(w.w); f[7] = bfhi(w.w); }
__device__ __forceinline__ v4u pack8f(const float (&f)[8]) { v4u w; w.x = pk2(f[0], f[1]); w.y = pk2(f[2], f[3]); w.z = pk2(f[4], f[5]); w.w = pk2(f[6], f[7]); return w; }

#define XB_TMO      128
#define XB_XCNT(j)  (256  + 64 * (j))
#define XB_XSUB(j)  (1280 + 64 * (j))
#define XB_XGEN(j)  (2304 + 64 * (j))
#define XB_TOP      3328
#define XB_TOPGEN   3392
#define XCD_BAR_WORDS 3456
#define XB_SPIN_CAP (1u << 18)

__device__ __forceinline__ unsigned xb_ld(unsigned* p)              { return __hip_atomic_load(p, __ATOMIC_RELAXED, __HIP_MEMORY_SCOPE_AGENT); }
__device__ __forceinline__ unsigned xb_add(unsigned* p, unsigned v) { return __hip_atomic_fetch_add(p, v, __ATOMIC_RELAXED, __HIP_MEMORY_SCOPE_AGENT); }
__device__ __forceinline__ unsigned xb_xcc_id() { return (unsigned)__builtin_amdgcn_s_getreg((3 << 11) | 20) & 0xFu; }
#define XB_SPIN(cond, bar) do { unsigned _sp = 0; while (cond) { __builtin_amdgcn_s_sleep(1); \
    if ((++_sp & 255u) == 0u) { if (xb_ld(&(bar)[XB_TMO])) break; if (_sp > XB_SPIN_CAP) { atomicAdd(&(bar)[XB_TMO], 1u); break; } } } } while (0)

struct XcdBarrier {
    unsigned* bar; unsigned x;
    volatile LAS unsigned* st;
};

__device__ __forceinline__ XcdBarrier xcd_barrier_post(unsigned* bar, volatile LAS unsigned* st) {
    XcdBarrier b; b.bar = bar; b.x = xb_xcc_id(); b.st = st;
    if (threadIdx.x == 0) (void)xb_add(&bar[XB_XCNT(b.x)], 1u);
    return b;
}
__device__ __forceinline__ void xcd_barrier_complete(unsigned* bar, unsigned x, unsigned& nloc, unsigned& nx) {
    const unsigned G = gridDim.x * gridDim.y * gridDim.z;
    unsigned sum, cnt, mine, sp = 0u;
    for (;;) {
        sum = 0u; cnt = 0u; mine = 0u;
#pragma unroll
        for (unsigned j = 0; j < 16; ++j) { const unsigned c = xb_ld(&bar[XB_XCNT(j)]); sum += c; cnt += (c > 0u) ? 1u : 0u; mine = (j == x) ? c : mine; }
        if (sum == G) break;
        __builtin_amdgcn_s_sleep(1);
        if ((++sp & 255u) == 0u) { if (xb_ld(&bar[XB_TMO])) break; if (sp > XB_SPIN_CAP) { atomicAdd(&bar[XB_TMO], 1u); break; } }
    }
    nloc = mine > 0u ? mine : 1u; nx = cnt > 0u ? cnt : 1u;
}

__device__ __forceinline__ void xcd_barrier(const XcdBarrier& b) {
    asm volatile("s_waitcnt vmcnt(0)" ::: "memory");
    __syncthreads();
    if (threadIdx.x == 0) {
        unsigned* bar = b.bar;
        __builtin_amdgcn_s_waitcnt(0);
        unsigned nloc = b.st[0], nx = b.st[1];
        if (nloc == 0u) { xcd_barrier_complete(bar, b.x, nloc, nx); b.st[0] = nloc; b.st[1] = nx; }
        const unsigned old = xb_add(&bar[XB_XSUB(b.x)], 1u);
        const unsigned gen = old / nloc;
        if (old + 1u == (gen + 1u) * nloc) {
            __builtin_amdgcn_fence(__ATOMIC_RELEASE, "agent");
            asm volatile("s_waitcnt vmcnt(0)" ::: "memory");
            const unsigned og = xb_add(&bar[XB_TOP], 1u);
            const unsigned tg = og / nx;
            if (og + 1u == (tg + 1u) * nx) xb_add(&bar[XB_TOPGEN], 1u);
            else XB_SPIN(xb_ld(&bar[XB_TOPGEN]) == tg, bar);
            __builtin_amdgcn_fence(__ATOMIC_ACQUIRE, "agent");
            xb_add(&bar[XB_XGEN(b.x)], 1u);
            asm volatile("s_waitcnt vmcnt(0)" ::: "memory");
        } else {
            XB_SPIN(xb_ld(&bar[XB_XGEN(b.x)]) == gen, bar);
            __builtin_amdgcn_fence(__ATOMIC_ACQUIRE, "agent");
            asm volatile("s_waitcnt vmcnt(0)" ::: "memory");
        }
    }
    __syncthreads();
}
enum { MAP_ID = 0, MAP_IN = 1, MAP_UP = 2 };
template <int MAP> __device__ __forceinline__ int map_col(int n, int off) {
    if (MAP == MAP_ID) return n + off;
    if (MAP == MAP_UP) { const int isv = n >= FF ? 1 : 0, c = n - isv * FF; return 256 * (c >> 7) + 128 * isv + (c & 127); }
    if (n < 512) return 256 * (n >> 7) + (n & 127);
    if (n < 1024) { const int c = n - 512; return 256 * (c >> 7) + 128 + (c & 127); }
    if (n < 2560) return n;
    if (n < 2576) return ZC_GA + (n - 2560);
    return n - 16;
}
template <int MAP> __device__ __forceinline__ void tr_item(const float* W, int K, int N, const float* gain, bf16* WT, int off, LAS float* scr, int item, int lane) {
    const int nblk = (N + 31) >> 5, kb = item / nblk, nb = item - kb * nblk, k0 = 64 * kb, n0 = 32 * nb;
    const int nl = n0 + (lane & 31); const bool ok = nl < N;
#pragma unroll 8
    for (int i = 0; i < 32; ++i) { const int kk = 2 * i + (lane >> 5); float v = ok ? W[(size_t)(k0 + kk) * N + nl] : 0.f; if (gain) v *= gain[k0 + kk]; scr[kk * 33 + (lane & 31)] = v; }
    LDS_WAIT(); asm volatile("" ::: "memory");
    const int c = lane & 7;
#pragma unroll
    for (int j = 0; j < 4; ++j) { const int n = (lane >> 3) + 8 * j; const LAS float* s = scr + (8 * c) * 33 + n;
        v4u o; o.x = pk2(s[0 * 33], s[1 * 33]); o.y = pk2(s[2 * 33], s[3 * 33]); o.z = pk2(s[4 * 33], s[5 * 33]); o.w = pk2(s[6 * 33], s[7 * 33]);
        if (n0 + n < N) *(GAS v4u*)(WT + (size_t)map_col<MAP>(n0 + n, off) * K + k0 + 8 * c) = o; }
    LDS_WAIT(); asm volatile("" ::: "memory");
}

template <int MAP> __device__ __forceinline__ void tr2_item(const float* W, int K, int N, const float* gain, bf16* WT, int off, int item, int lane) {
    const int ngrp = (N + 63) >> 6, kb = item / ngrp, nb = item - kb * ngrp, k0 = 64 * kb, n = 64 * nb + lane;
    if (n >= N) return;
    const float* src = W + (size_t)k0 * N + n;
    float v[64];
#pragma unroll
    for (int r = 0; r < 64; ++r) v[r] = __builtin_nontemporal_load((const GAS float*)(src + (size_t)r * N));
    if (gain) {
#pragma unroll
        for (int r = 0; r < 64; ++r) v[r] *= gain[k0 + r]; }
    bf16* dst = WT + (size_t)map_col<MAP>(n, off) * K + k0;
#pragma unroll
    for (int kg = 0; kg < 8; ++kg) { v4u o; o.x = pk2(v[8 * kg], v[8 * kg + 1]); o.y = pk2(v[8 * kg + 2], v[8 * kg + 3]); o.z = pk2(v[8 * kg + 4], v[8 * kg + 5]); o.w = pk2(v[8 * kg + 6], v[8 * kg + 7]);
        *(GAS v4u*)(dst + kg * 8) = o; }
}

__device__ __forceinline__ int map_col_rt(int map, int n, int off) {
    if (map == MAP_ID) return n + off;
    if (map == MAP_UP) return map_col<MAP_UP>(n, 0);
    return map_col<MAP_IN>(n, 0);
}
constexpr int CT_IN = 32 * 44, CT_GT = 32 * 48, CT_CA = 8 * 16, CT_GL = 8 * 16, CT_MO = 16 * 16, CT_OU = 32 * 16, CT_UP = 32 * 88, CT_DN = 88 * 16, CT_PG = 32 * 16, CT_PL = 4 * 16;
constexpr int CT_LAYER = CT_IN + CT_GT + CT_CA + CT_GL + CT_MO + CT_OU + CT_UP + CT_DN + CT_PG + CT_PL;
struct CvTile { const float* W; const float* gain; bf16* WT; int K, N, map, off, k0, n0, ldk; };
__device__ __forceinline__ void conv_branch_item(int item, const bf16* zb, const float* cw, const float* cb, const float* lg, const float* lb, bf16* aconv, LAS float* XA, int tid) {
    const int m0 = item * 32, t0 = m0 & (SEQ - 1), lane = tid & 63, wave = tid >> 6;
    { v4u ld[8];
#pragma unroll
      for (int pass = 0; pass < 8; ++pass) { const int r = pass * 8 + wave, c0 = lane * 8; ld[pass] = (v4u){0u, 0u, 0u, 0u};
          if (r < 62 && t0 - 30 + r >= 0) ld[pass] = *(const GAS v4u*)(zb + (size_t)(m0 - 30 + r) * CCH + c0); }
#pragma unroll
      for (int pass = 0; pass < 8; ++pass) { const int r = pass * 8 + wave, c0 = lane * 8;
          if (r < 62) { float a[8]; unpack8(ld[pass], a);
              *(LAS f32x4*)(XA + r * 512 + c0) = (f32x4){a[0], a[1], a[2], a[3]}; *(LAS f32x4*)(XA + r * 512 + c0 + 4) = (f32x4){a[4], a[5], a[6], a[7]}; } } }
    __syncthreads();
    float w[CWID];
#pragma unroll
    for (int j = 0; j < CWID; ++j) w[j] = cw[j * CCH + tid];
    const float bias = cb[tid];
    float yv[32];
#pragma unroll
    for (int rb = 0; rb < 4; ++rb) { float x[38];
#pragma unroll
        for (int i = 0; i < 38; ++i) x[i] = XA[(rb * 8 + i) * 512 + tid];
#pragma unroll
        for (int r = 0; r < 8; ++r) { float y = bias;
#pragma unroll
            for (int j = 0; j < CWID; ++j) y = fmaf(w[j], x[r + j], y);
            yv[rb * 8 + r] = y; } }
    __syncthreads();
#pragma unroll
    for (int r = 0; r < 32; ++r) XA[r * 512 + tid] = yv[r];
    __syncthreads();
    const f32x4 g0 = *(const f32x4*)(lg + lane * 8), g1 = *(const f32x4*)(lg + lane * 8 + 4), b0 = *(const f32x4*)(lb + lane * 8), b1 = *(const f32x4*)(lb + lane * 8 + 4);
#pragma unroll 1
    for (int q = 0; q < 4; ++q) { const int r = wave * 4 + q, c0 = lane * 8;
        const f32x4 a0 = *(const LAS f32x4*)(XA + r * 512 + c0), a1 = *(const LAS f32x4*)(XA + r * 512 + c0 + 4);
        float v[8] = {a0[0], a0[1], a0[2], a0[3], a1[0], a1[1], a1[2], a1[3]};
        float s = 0.f;
#pragma unroll
        for (int i = 0; i < 8; ++i) s += v[i];
        const float mean = wave_sum(s) * (1.f / CCH); float q2 = 0.f;
#pragma unroll
        for (int i = 0; i < 8; ++i) { v[i] -= mean; q2 += v[i] * v[i]; }
        const float rstd = __builtin_amdgcn_rsqf(wave_sum(q2) * (1.f / CCH) + RMS_EPS);
        const float gg[8] = {g0[0], g0[1], g0[2], g0[3], g1[0], g1[1], g1[2], g1[3]}, bb[8] = {b0[0], b0[1], b0[2], b0[3], b1[0], b1[1], b1[2], b1[3]};
        float o[8];
#pragma unroll
        for (int i = 0; i < 8; ++i) { const float y = v[i] * rstd * gg[i] + bb[i]; o[i] = y * sigm(y); }
        *(GAS v4u*)(aconv + (size_t)(m0 + r) * 2048 + c0) = pack8f(o); }
    __syncthreads();
}

__device__ __forceinline__ void kmean_item(int item, const bf16* zb, float* kmean, LAS float* CS, int tid) {
    const int b = item >> 7, n = (item >> 3) & 15, h = item & 7, lane = tid & 63, wave = tid >> 6;
    const int m0 = ((BATCH + b) * MH + h) * SEQ + n * MBLK, c0 = (lane & 15) * 8;
    float cs[8] = {0.f, 0.f, 0.f, 0.f, 0.f, 0.f, 0.f, 0.f};
#pragma unroll
    for (int p = 0; p < 8; ++p) { const int row = m0 + wave * 32 + p * 4 + (lane >> 4); float v[8]; unpack8(*(const GAS v4u*)(zb + (size_t)row * MHD + c0), v);
#pragma unroll
        for (int i = 0; i < 8; ++i) cs[i] += v[i]; }
#pragma unroll
    for (int i = 0; i < 8; ++i) { cs[i] += __shfl_xor(cs[i], 16); cs[i] += __shfl_xor(cs[i], 32); }
    if (lane < 16) {
#pragma unroll
        for (int i = 0; i < 8; ++i) CS[wave * 128 + c0 + i] = cs[i]; }
    __syncthreads();
    if (tid < 128) { float s = 0.f;
#pragma unroll
        for (int w = 0; w < 8; ++w) s += CS[w * 128 + tid];
        kmean[((size_t)(b * MH + h) * MNB + n) * MHD + tid] = s * (1.f / MBLK); }
    __syncthreads();
}

__device__ __forceinline__ void moba_combine(size_t i, const bf16* o0, const bf16* o1, const float* ml, bf16* out) {
    const size_t row = i >> 7; const int h = (int)(i >> 4) & 7;
    typedef float f32x2v __attribute__((ext_vector_type(2)));
    const f32x2v a = *(const f32x2v*)(ml + (row * 8 + h) * 2), b = *(const f32x2v*)(ml + ((size_t)T * 8 + row * 8 + h) * 2);
    constexpr float C2 = 1.4426950408889634f * 0.08838834764831845f;
    const float m = fmaxf(a.x, b.x), w0 = a.y * __builtin_amdgcn_exp2f((a.x - m) * C2), w1 = b.y * __builtin_amdgcn_exp2f((b.x - m) * C2), inv = __builtin_amdgcn_rcpf(w0 + w1);
    float x[8], y[8]; unpack8(*((const GAS v4u*)o0 + i), x); unpack8(*((const GAS v4u*)o1 + i), y);
#pragma unroll
    for (int q = 0; q < 8; ++q) x[q] = (w0 * x[q] + w1 * y[q]) * inv;
    *(GAS v4u*)(out + row * 2048 + (i & 127) * 8) = pack8f(x);
}
constexpr int GL_LA = 0, GL_W2 = 16640, GL_BA = 20736, GL_QT = 21504, GL_KT = 30720, GL_KD = 39936, GL_VT = 49152, GL_PP = 67584, GL_END = 76800, GLS = 72;
struct GlaLocRegs { f32x4 gav[4]; v4u qraw, kraw, v0raw, v1raw; };
__device__ __forceinline__ void gla_local_load(int item, const bf16* zb, const float* ga, GlaLocRegs& R, int tid) {
    const int bh = item >> 6, c = item & 63, b = bh >> 2, h = bh & 3, m0 = b * SEQ + c * GCH, t = tid >> 3, d0 = (tid & 7) * 8, e0 = (tid & 7) * 16;
#pragma unroll
    for (int q = 0; q < 4; ++q) R.gav[q] = *(const GAS f32x4*)(ga + (size_t)(m0 + t) * GRANK + 4 * q);
    R.qraw = *(const GAS v4u*)(zb + (size_t)(m0 + t) * ZN + ZC_GQ + h * GDK + d0); R.kraw = *(const GAS v4u*)(zb + (size_t)(m0 + t) * ZN + ZC_GK + h * GDK + d0);
    const bf16* vp = zb + (size_t)(m0 + t) * ZN + ZC_GV + h * GDV + e0; R.v0raw = *(const GAS v4u*)vp; R.v1raw = *(const GAS v4u*)(vp + 8);
}
__device__ __forceinline__ void gla_local_compute(int item, const GlaLocRegs& R, const float* wa2, const float* ba, bf16* gqt, float* gintra, float* gdelta, float* gdec, LAS unsigned char* L, int tid) {
    const int bh = item >> 6, c = item & 63, b = bh >> 2, h = bh & 3, m0 = b * SEQ + c * GCH, lane = tid & 63, wave = tid >> 6, l15 = lane & 15, quad = lane >> 4;
    LAS float* LA = (LAS float*)(L + GL_LA); LAS float* W2 = (LAS float*)(L + GL_W2); LAS float* BA = (LAS float*)(L + GL_BA);
    LAS bf16* QT = (LAS bf16*)(L + GL_QT); LAS bf16* KT = (LAS bf16*)(L + GL_KT); LAS bf16* KD = (LAS bf16*)(L + GL_KD); LAS bf16* VT = (LAS bf16*)(L + GL_VT); LAS bf16* PP = (LAS bf16*)(L + GL_PP);
    const int t = tid >> 3, d0 = (tid & 7) * 8;
    const f32x4 (&gav)[4] = R.gav; const v4u qraw = R.qraw, kraw = R.kraw;
    for (int e = tid; e < GRANK * GDK; e += NTHR) W2[e] = wa2[(e >> 6) * (GH * GDK) + h * GDK + (e & 63)];
    if (tid < GDK) BA[tid] = ba[h * GDK + tid];
    { const int e0 = (tid & 7) * 16;
        float v0[8], v1[8]; unpack8(R.v0raw, v0); unpack8(R.v1raw, v1);
#pragma unroll
        for (int i = 0; i < 8; ++i) { VT[(e0 + i) * GLS + t] = (bf16)f2bf(v0[i]); VT[(e0 + 8 + i) * GLS + t] = (bf16)f2bf(v1[i]); } }
    __syncthreads();
    { float g[GRANK];
#pragma unroll
        for (int q = 0; q < 4; ++q) { const f32x4 x = gav[q]; g[4 * q] = x[0]; g[4 * q + 1] = x[1]; g[4 * q + 2] = x[2]; g[4 * q + 3] = x[3]; }
#pragma unroll
        for (int i = 0; i < 8; ++i) { float x = BA[d0 + i];
#pragma unroll
            for (int r = 0; r < GRANK; ++r) x = fmaf(g[r], W2[r * GDK + d0 + i], x);
            const float ls = fminf(x, 0.f) - __logf(1.0f + __expf(-fabsf(x)));
            LA[t * 65 + d0 + i] = ls * (1.0f / 16.0f); } }
    __syncthreads();
    if (tid < GDK) { float s = 0.f;
#pragma unroll 8
        for (int tt = 0; tt < GCH; ++tt) { s += LA[tt * 65 + tid]; LA[tt * 65 + tid] = s; } }
    __syncthreads();
    { float q[8], k[8]; unpack8(qraw, q); unpack8(kraw, k);
        float qt[8], kt[8];
#pragma unroll
        for (int i = 0; i < 8; ++i) { const float bc = LA[t * 65 + d0 + i], bl = LA[63 * 65 + d0 + i];
            qt[i] = q[i] * 0.125f * __expf(bc); kt[i] = k[i] * __expf(-bc); KD[(d0 + i) * GLS + t] = (bf16)f2bf(k[i] * __expf(bl - bc));
            if (t == GCH - 1) gdec[(size_t)item * GDK + d0 + i] = __expf(bl); }
        const v4u qw = pack8f(qt), kw = pack8f(kt);
        *(LAS v4u*)(QT + t * GLS + d0) = qw; *(LAS v4u*)(KT + t * GLS + d0) = kw;
        *(GAS v4u*)(gqt + (size_t)(m0 + t) * (GH * GDK) + h * GDK + d0) = qw; }
    __syncthreads();
#pragma unroll
    for (int i = 0; i < 2; ++i) { const int tile = wave * 2 + i, tr = tile >> 2, tc = tile & 3; f32x4 acc = {0.f, 0.f, 0.f, 0.f};
#pragma unroll
        for (int k0 = 0; k0 < 64; k0 += 32) { const bf16x8 a = *(const LAS bf16x8*)(QT + (tr * 16 + l15) * GLS + k0 + quad * 8), bb = *(const LAS bf16x8*)(KT + (tc * 16 + l15) * GLS + k0 + quad * 8);
            acc = __builtin_amdgcn_mfma_f32_16x16x32_bf16(a, bb, acc, 0, 0, 0); }
#pragma unroll
        for (int r = 0; r < 4; ++r) { const int tt = tr * 16 + quad * 4 + r, ss = tc * 16 + l15; PP[tt * GLS + ss] = (bf16)f2bf(ss <= tt ? acc[r] : 0.f); } }
    __syncthreads();
#pragma unroll
    for (int i = 0; i < 4; ++i) { const int tile = wave * 4 + i, tr = tile >> 3, te = tile & 7; f32x4 acc = {0.f, 0.f, 0.f, 0.f};
#pragma unroll
        for (int k0 = 0; k0 < 64; k0 += 32) { const bf16x8 a = *(const LAS bf16x8*)(PP + (tr * 16 + l15) * GLS + k0 + quad * 8), bb = *(const LAS bf16x8*)(VT + (te * 16 + l15) * GLS + k0 + quad * 8);
            acc = __builtin_amdgcn_mfma_f32_16x16x32_bf16(a, bb, acc, 0, 0, 0); }
#pragma unroll
        for (int r = 0; r < 4; ++r) gintra[(size_t)(m0 + tr * 16 + quad * 4 + r) * (GH * GDV) + h * GDV + te * 16 + l15] = acc[r]; }
#pragma unroll
    for (int i = 0; i < 4; ++i) { const int tile = wave * 4 + i, te = tile >> 2, td = tile & 3; f32x4 acc = {0.f, 0.f, 0.f, 0.f};
#pragma unroll
        for (int k0 = 0; k0 < 64; k0 += 32) { const bf16x8 a = *(const LAS bf16x8*)(VT + (te * 16 + l15) * GLS + k0 + quad * 8), bb = *(const LAS bf16x8*)(KD + (td * 16 + l15) * GLS + k0 + quad * 8);
            acc = __builtin_amdgcn_mfma_f32_16x16x32_bf16(a, bb, acc, 0, 0, 0); }
#pragma unroll
        for (int r = 0; r < 4; ++r) gdelta[(size_t)item * (GDK * GDV) + (te * 16 + quad * 4 + r) * GDK + td * 16 + l15] = acc[r]; }
    __syncthreads();
}
__device__ __forceinline__ void gla_local_item(int item, const bf16* zb, const float* ga, const float* wa2, const float* ba, bf16* gqt, float* gintra, float* gdelta, float* gdec, LAS unsigned char* L, int tid) {
    GlaLocRegs R; gla_local_load(item, zb, ga, R, tid); gla_local_compute(item, R, wa2, ba, gqt, gintra, gdelta, gdec, L, tid); }
__device__ __forceinline__ void gla_scan(int gid, const float* gdelta, const float* gdec, bf16* gst) {
    const int bh = gid >> 13, idx = gid & 8191, d = idx & 63;
    float dl[GNC], dc[GNC];
#pragma unroll
    for (int c = 0; c < GNC; ++c) { const size_t it = (size_t)bh * GNC + c; dl[c] = gdelta[it * 8192 + idx]; dc[c] = gdec[it * GDK + d]; }
    float S = 0.f;
#pragma unroll
    for (int c = 0; c < GNC; ++c) { gst[((size_t)bh * GNC + c) * 8192 + idx] = (bf16)f2bf(S); S = fmaf(S, dc[c], dl[c]); }
}
struct GlaOutRegs { bf16x8 a[2]; bf16x8 bb[2][4]; float gi[4][4]; unsigned short rvb[4][4]; float ngv[4]; };
__device__ __forceinline__ void gla_out_load(int item, const bf16* zb, const bf16* gqt, const bf16* gst, const float* gintra, const float* ng, GlaOutRegs& R, int tid) {
    const int bh = item >> 6, c = item & 63, b = bh >> 2, h = bh & 3, m0 = b * SEQ + c * GCH, lane = tid & 63, wave = tid >> 6, l15 = lane & 15, quad = lane >> 4;
    const int tr = wave & 3, half = wave >> 2;
#pragma unroll
    for (int kk = 0; kk < 2; ++kk) { const int k0 = 32 * kk; R.a[kk] = *(const GAS bf16x8*)(gqt + (size_t)(m0 + tr * 16 + l15) * (GH * GDK) + h * GDK + k0 + quad * 8);
#pragma unroll
        for (int i = 0; i < 4; ++i) { const int te = half * 4 + i; R.bb[kk][i] = *(const GAS bf16x8*)(gst + (size_t)item * 8192 + (te * 16 + l15) * GDK + k0 + quad * 8); } }
#pragma unroll
    for (int i = 0; i < 4; ++i) { const int e = (half * 4 + i) * 16 + l15; R.ngv[i] = ng[e];
#pragma unroll
        for (int r = 0; r < 4; ++r) { R.rvb[r][i] = *(const GAS unsigned short*)(zb + (size_t)(m0 + tr * 16 + quad * 4 + r) * ZN + ZC_GR + h * GDV + e);
            R.gi[i][r] = gintra[(size_t)(m0 + tr * 16 + quad * 4 + r) * (GH * GDV) + h * GDV + e]; } }
}
__device__ __forceinline__ void gla_out_compute(int item, const GlaOutRegs& R, bf16* ogla, LAS float* SS, int tid) {
    const int bh = item >> 6, c = item & 63, b = bh >> 2, h = bh & 3, m0 = b * SEQ + c * GCH, lane = tid & 63, wave = tid >> 6, l15 = lane & 15, quad = lane >> 4;
    const int tr = wave & 3, half = wave >> 2;
    f32x4 acc[4];
#pragma unroll
    for (int i = 0; i < 4; ++i) acc[i] = (f32x4){0.f, 0.f, 0.f, 0.f};
#pragma unroll
    for (int kk = 0; kk < 2; ++kk)
#pragma unroll
        for (int i = 0; i < 4; ++i) acc[i] = __builtin_amdgcn_mfma_f32_16x16x32_bf16(R.a[kk], R.bb[kk][i], acc[i], 0, 0, 0);
    float ss[4] = {0.f, 0.f, 0.f, 0.f};
#pragma unroll
    for (int i = 0; i < 4; ++i)
#pragma unroll
        for (int r = 0; r < 4; ++r) { acc[i][r] += R.gi[i][r]; ss[r] += acc[i][r] * acc[i][r]; }
#pragma unroll
    for (int r = 0; r < 4; ++r) { ss[r] += __shfl_xor(ss[r], 1); ss[r] += __shfl_xor(ss[r], 2); ss[r] += __shfl_xor(ss[r], 4); ss[r] += __shfl_xor(ss[r], 8);
        if (l15 == 0) SS[wave * 16 + quad * 4 + r] = ss[r]; }
    __syncthreads();
#pragma unroll
    for (int r = 0; r < 4; ++r) { const float tot = SS[wave * 16 + quad * 4 + r] + SS[(wave ^ 4) * 16 + quad * 4 + r];
        const float rstd = __builtin_amdgcn_rsqf(tot * (1.f / GDV) + RMS_EPS); const size_t row = (size_t)(m0 + tr * 16 + quad * 4 + r);
#pragma unroll
        for (int i = 0; i < 4; ++i) { const int e = (half * 4 + i) * 16 + l15; const float rv = bflo((unsigned)R.rvb[r][i]);
            ogla[row * 2048 + h * GDV + e] = (bf16)f2bf(acc[i][r] * rstd * R.ngv[i] * (rv * sigm(rv))); } }
    __syncthreads();
}
__device__ __forceinline__ void gla_out_item(int item, const bf16* zb, const bf16* gqt, const bf16* gst, const float* gintra, const float* ng, bf16* ogla, LAS float* SS, int tid) {
    GlaOutRegs R; gla_out_load(item, zb, gqt, gst, gintra, ng, R, tid); gla_out_compute(item, R, ogla, SS, tid); }
__device__ __forceinline__ void ffn_fix_task(int grp, int s, const float* edge, const float* fw, bf16* affn) {
    const int c0 = s * 8, colg = 256 * (c0 >> 7) + (c0 & 127);
    const bool first = ((grp * 64) & (SEQ - 1)) == 0;
    float wg[3][8], wv[3][8];
#pragma unroll
    for (int j = 0; j < 3; ++j) { const f32x4 a0 = *(const f32x4*)(fw + (size_t)j * FF2 + c0), a1 = *(const f32x4*)(fw + (size_t)j * FF2 + c0 + 4), b0 = *(const f32x4*)(fw + (size_t)j * FF2 + FF + c0), b1 = *(const f32x4*)(fw + (size_t)j * FF2 + FF + c0 + 4);
#pragma unroll
        for (int i = 0; i < 4; ++i) { wg[j][i] = a0[i]; wg[j][4 + i] = a1[i]; wv[j][i] = b0[i]; wv[j][4 + i] = b1[i]; } }
    float g[4][8], v[4][8];
#pragma unroll
    for (int r = 0; r < 4; ++r) { const bool z = first && r < 2; const float* p = edge + ((size_t)(r < 2 ? grp - 1 : grp) * 4 + (r < 2 ? r : r)) * FF2 + colg;
        const f32x4 a0 = z ? (f32x4){0.f, 0.f, 0.f, 0.f} : *(const GAS f32x4*)p, a1 = z ? (f32x4){0.f, 0.f, 0.f, 0.f} : *(const GAS f32x4*)(p + 4), b0 = z ? (f32x4){0.f, 0.f, 0.f, 0.f} : *(const GAS f32x4*)(p + 128), b1 = z ? (f32x4){0.f, 0.f, 0.f, 0.f} : *(const GAS f32x4*)(p + 132);
#pragma unroll
        for (int i = 0; i < 4; ++i) { g[r][i] = a0[i]; g[r][4 + i] = a1[i]; v[r][i] = b0[i]; v[r][4 + i] = b1[i]; } }
#pragma unroll
    for (int r = 0; r < 2; ++r) { float o[8];
#pragma unroll
        for (int i = 0; i < 8; ++i) { const float ug = wg[0][i] * g[r][i] + wg[1][i] * g[r + 1][i] + wg[2][i] * g[r + 2][i], uv = wv[0][i] * v[r][i] + wv[1][i] * v[r + 1][i] + wv[2][i] * v[r + 2][i]; o[i] = ug * sigm(ug) * uv; }
        *(GAS v4u*)(affn + (size_t)(grp * 64 + r) * FF + c0) = pack8f(o); }
}

#ifndef MK_N_LAUNCHES
#define MK_N_LAUNCHES 1
#endif
constexpr int N_PHASES = 1 + 10 * DEPTH;
struct Args { const float* in[26]; float* out; unsigned char* ws; int ph_lo, ph_hi, one, pad; };
constexpr int PTAB_OFF = LDSCTL_OFF + 1024;
__device__ __forceinline__ unsigned long long ldp_raw(const LAS unsigned long long* tab, int i) {
    const unsigned long long v = tab[i]; const unsigned a = __builtin_amdgcn_readfirstlane((unsigned)v), b = __builtin_amdgcn_readfirstlane((unsigned)(v >> 32));
    return ((unsigned long long)b << 32) | a; }
#define INP(i) ((const float*)(const GAS float*)ldp_raw(PT, (i)))
#define WSB() ((unsigned char*)(GAS unsigned char*)ldp_raw(PT, 27))
#define OUTP() ((float*)(GAS float*)ldp_raw(PT, 26))
#define RSTD_TABLE(S_, part_, TMP_) do { pg8::Unit uu_; int pmv_[6]; \
        _Pragma("unroll") for (int i_ = 0; i_ < 6; ++i_) pmv_[i_] = S_.next(i_, uu_) ? uu_.pm : -1; \
        { const int row_ = tid & 255, hf_ = tid >> 8; f32x4 v_[6][4];                     \
          _Pragma("unroll") for (int i_ = 0; i_ < 6; ++i_) { const int pm_ = pmv_[i_] < 0 ? (pmv_[0] < 0 ? 0 : pmv_[0]) : pmv_[i_]; const float* p_ = (part_) + (size_t)(pm_ * 256 + row_) * 32 + hf_ * 16; \
              _Pragma("unroll") for (int q_ = 0; q_ < 4; ++q_) v_[i_][q_] = *(const GAS f32x4*)(p_ + 4 * q_); } \
          _Pragma("unroll") for (int i_ = 0; i_ < 6; ++i_) { float s_ = 0.f; _Pragma("unroll") for (int q_ = 0; q_ < 4; ++q_) s_ += (v_[i_][q_][0] + v_[i_][q_][1]) + (v_[i_][q_][2] + v_[i_][q_][3]); \
              ((LAS float*)(L + RING_OFF + (TMP_)))[(i_ * 2 + hf_) * 256 + row_] = s_; } } \
        __syncthreads(); \
        for (int j_ = tid; j_ < 6 * 256; j_ += NTHR) { const int i_ = j_ >> 8, r_ = j_ & 255; const LAS float* t_ = (const LAS float*)(L + RING_OFF + (TMP_)); \
            ((LAS float*)(L + RT_OFF))[j_] = __builtin_amdgcn_rsqf((t_[(i_ * 2) * 256 + r_] + t_[(i_ * 2 + 1) * 256 + r_]) * (1.0f / DM) + RMS_EPS); } \
        if (tid == 0) { _Pragma("unroll") for (int i_ = 0; i_ < 6; ++i_) if (pmv_[i_] >= 0) ((LAS int*)(L + SLOT_OFF))[pmv_[i_]] = i_; } \
        __syncthreads(); } while (0)
__global__ void __launch_bounds__(NTHR, 2) trunk_fwd(Args args) {
    extern __shared__ __attribute__((aligned(16))) unsigned char lds[];
    LAS unsigned char* L = (LAS unsigned char*)lds;
    volatile LAS unsigned* MISC = (volatile LAS unsigned*)(L + MISC_OFF);
    const LAS unsigned long long* PT = (const LAS unsigned long long*)(L + PTAB_OFF);
    for (int u = threadIdx.x; u < (LDS_BYTES - LDSCTL_OFF) / 4; u += NTHR) ((LAS unsigned*)(L + LDSCTL_OFF))[u] = 0u;
    __syncthreads();
    { const int tid = threadIdx.x;
    if (tid < 26) ((LAS unsigned long long*)(L + PTAB_OFF))[tid] = (unsigned long long)args.in[tid];
    if (tid == 26) ((LAS unsigned long long*)(L + PTAB_OFF))[26] = (unsigned long long)args.out;
    if (tid == 27) ((LAS unsigned long long*)(L + PTAB_OFF))[27] = (unsigned long long)args.ws; }
    __syncthreads();
    XcdBarrier bar; bar.bar = (unsigned*)(args.ws + WS_CTL) + CW_BAR; bar.x = 0; bar.st = nullptr;
    if (args.one) bar = xcd_barrier_post((unsigned*)(args.ws + WS_CTL) + CW_BAR, MISC + 8);
    const int lo = args.ph_lo, hi = args.ph_hi;
#ifndef PHMASK
#define PHMASK 0xFFFF
#endif
#define IN(k) (lo <= (k) && (k) < hi)
#define EN(b) (((PHMASK) >> (b)) & 1)
#define SEAM(k) do { if (IN(k) && IN((k) + 1)) xcd_barrier(bar); } while (0)
#define GRIDV() int tid = threadIdx.x; asm volatile("" : "+v"(tid)); const int lane = tid & 63, wave = __builtin_amdgcn_readfirstlane(tid >> 6); (void)lane; (void)wave; const int G = gridDim.x, bx = blockIdx.x; const int vcu = (G % 8 == 0) ? (bx % 8) * (G / 8) + bx / 8 : bx; (void)vcu
#define WP(T_, off) ((T_*)(ws + (off)))

    if (EN(0) && IN(0)) {
        GRIDV(); unsigned char* ws = WSB(); const int gw = vcu * NWAVES + wave, NGW = G * NWAVES;
        {
#define CV_DECODE(id_, tl_) do { const int l_ = (id_) / CT_LAYER; int r_ = (id_) - l_ * CT_LAYER; unsigned char* wl_ = ws + WS_W + (size_t)l_ * W_LAYER; int ng_; \
            if (r_ < CT_IN) { tl_.W = INP(3) + (size_t)l_ * DM * IN_COLS; tl_.K = DM; tl_.N = IN_COLS; tl_.gain = INP(2) + l_ * DM; tl_.WT = (bf16*)(wl_ + WO_W1); tl_.ldk = tl_.K; tl_.map = MAP_IN; tl_.off = 0; ng_ = 44; } \
            else if ((r_ -= CT_IN) < CT_GT) { tl_.W = INP(16) + (size_t)l_ * DM * NGATE; tl_.K = DM; tl_.N = NGATE; tl_.gain = INP(2) + l_ * DM; tl_.WT = (bf16*)(wl_ + WO_W1); tl_.ldk = tl_.K; tl_.map = MAP_ID; tl_.off = ZC_GATE; ng_ = 48; } \
            else if ((r_ -= CT_GT) < CT_CA) { tl_.W = INP(8) + (size_t)l_ * CCH * DM; tl_.K = CCH; tl_.N = DM; tl_.gain = nullptr; tl_.WT = (bf16*)(wl_ + WO_CA); tl_.ldk = 2048; tl_.map = MAP_ID; tl_.off = 0; ng_ = 16; } \
            else if ((r_ -= CT_CA) < CT_GL) { tl_.W = INP(12) + (size_t)l_ * 512 * DM; tl_.K = 512; tl_.N = DM; tl_.gain = nullptr; tl_.WT = (bf16*)(wl_ + WO_CA) + 512; tl_.ldk = 2048; tl_.map = MAP_ID; tl_.off = 0; ng_ = 16; } \
            else if ((r_ -= CT_GL) < CT_MO) { tl_.W = INP(15) + (size_t)l_ * 1024 * DM; tl_.K = 1024; tl_.N = DM; tl_.gain = nullptr; tl_.WT = (bf16*)(wl_ + WO_CA) + 1024; tl_.ldk = 2048; tl_.map = MAP_ID; tl_.off = 0; ng_ = 16; } \
            else if ((r_ -= CT_MO) < CT_OU) { tl_.W = INP(18) + (size_t)l_ * DM * DM; tl_.K = DM; tl_.N = DM; tl_.gain = nullptr; tl_.WT = (bf16*)(wl_ + WO_OU); tl_.ldk = tl_.K; tl_.map = MAP_ID; tl_.off = 0; ng_ = 16; } \
            else if ((r_ -= CT_OU) < CT_UP) { tl_.W = INP(20) + (size_t)l_ * DM * FF2; tl_.K = DM; tl_.N = FF2; tl_.gain = INP(19) + l_ * DM; tl_.WT = (bf16*)(wl_ + WO_UP); tl_.ldk = tl_.K; tl_.map = MAP_UP; tl_.off = 0; ng_ = 88; } \
            else if ((r_ -= CT_UP) < CT_DN) { tl_.W = INP(22) + (size_t)l_ * FF * DM; tl_.K = FF; tl_.N = DM; tl_.gain = nullptr; tl_.WT = (bf16*)(wl_ + WO_DN); tl_.ldk = tl_.K; tl_.map = MAP_ID; tl_.off = 0; ng_ = 16; } \
            else if ((r_ -= CT_DN) < CT_PG) { tl_.W = INP(24) + (size_t)l_ * DM * DM; tl_.K = DM; tl_.N = DM; tl_.gain = INP(23) + l_ * DM; tl_.WT = (bf16*)(wl_ + WO_PG); tl_.ldk = tl_.K; tl_.map = MAP_ID; tl_.off = 0; ng_ = 16; } \
            else { r_ -= CT_PG; tl_.W = INP(25) + (size_t)l_ * PLE * DM; tl_.K = PLE; tl_.N = DM; tl_.gain = nullptr; tl_.WT = (bf16*)(wl_ + WO_PL); tl_.ldk = tl_.K; tl_.map = MAP_ID; tl_.off = 0; ng_ = 16; } \
            { const int kb_ = r_ / ng_; tl_.k0 = 64 * kb_; tl_.n0 = 128 * (r_ - kb_ * ng_); } } while (0)
#define CV_ISSUE(i_) do { CvTile ti_; CV_DECODE(vcu + (i_) * G, ti_); \
            _Pragma("unroll") for (int j_ = 0; j_ < 4; ++j_) { const int p_ = wave * 4 + j_; \
                __builtin_amdgcn_global_load_lds((const unsigned*)(ti_.W + (size_t)(ti_.k0 + 2 * p_ + (lane >> 5)) * ti_.N + ti_.n0 + (lane & 31) * 4), \
                                                 (LAS unsigned*)(L + RING_OFF + ((i_) & 3) * 32768 + p_ * 1024), 16, 0, 2); } } while (0)
            const int ntl = (DEPTH * CT_LAYER - vcu + G - 1) / G;
            for (int i = 0; i < 3 && i < ntl; ++i) CV_ISSUE(i);
            const int c = tid & 127, kq = __builtin_amdgcn_readfirstlane(tid >> 7);
            for (int i = 0; i < ntl; ++i) {
                if (i + 3 >= ntl) asm volatile("s_waitcnt vmcnt(0)" ::: "memory");
                else if (i == 0) asm volatile("s_waitcnt vmcnt(8)" ::: "memory");
                else if (i == 1) asm volatile("s_waitcnt vmcnt(10)" ::: "memory");
                else if (i == 2) asm volatile("s_waitcnt vmcnt(12)" ::: "memory");
                else asm volatile("s_waitcnt vmcnt(14)" ::: "memory");
                __builtin_amdgcn_s_barrier(); asm volatile("" ::: "memory");
                if (i + 3 < ntl) CV_ISSUE(i + 3);
                CvTile tc; CV_DECODE(vcu + i * G, tc);
                const LAS float* sp = (const LAS float*)(L + RING_OFF + (i & 3) * 32768) + (kq * 16) * 128 + c;
                float v[16];
#pragma unroll
                for (int r = 0; r < 16; ++r) v[r] = sp[r * 128];
                if (tc.gain) {
#pragma unroll
                    for (int r = 0; r < 16; ++r) v[r] *= ((const __attribute__((address_space(4))) float*)(unsigned long long)tc.gain)[tc.k0 + kq * 16 + r]; }
                bf16* dp = tc.WT + (size_t)map_col_rt(tc.map, tc.n0 + c, tc.off) * tc.ldk + tc.k0 + kq * 16;
                v4u o0, o1; o0.x = pk2(v[0], v[1]); o0.y = pk2(v[2], v[3]); o0.z = pk2(v[4], v[5]); o0.w = pk2(v[6], v[7]); o1.x = pk2(v[8], v[9]); o1.y = pk2(v[10], v[11]); o1.z = pk2(v[12], v[13]); o1.w = pk2(v[14], v[15]);
                *(GAS v4u*)dp = o0; *(GAS v4u*)(dp + 8) = o1;
            }
            asm volatile("s_waitcnt vmcnt(0)" ::: "memory"); __syncthreads();
#undef CV_ISSUE
#undef CV_DECODE
            for (int it = gw; it < DEPTH * 32; it += NGW) { const int l = it >> 5, kb = it & 31;
                tr2_item<MAP_IN>(INP(3) + (size_t)l * DM * IN_COLS, DM, IN_COLS, INP(2) + l * DM, (bf16*)(ws + WS_W + (size_t)l * W_LAYER + WO_W1), 0, kb * 89 + 88, lane); }
        }
        const size_t gt = (size_t)vcu * NTHR + tid, NGT = (size_t)G * NTHR;
        for (size_t i = gt; i < (size_t)DEPTH * 240 * (DM / 8); i += NGT) {
            const int l = (int)(i / (240 * (DM / 8))); const size_t r = i - (size_t)l * (240 * (DM / 8));
            *(GAS v4u*)(ws + WS_W + (size_t)l * W_LAYER + WO_W1 + ((size_t)(ZC_GA + 16) * DM + r * 8) * 2) = (v4u){0u, 0u, 0u, 0u}; }
        const float* x_in = INP(0); bf16* XBA = WP(bf16, WS_XBA); float* ROWSS = WP(float, WS_RSP);
        for (int m = gw; m < T; m += NGW) {
            const GAS f32x4* xr = (const GAS f32x4*)(x_in + (size_t)m * DM) + lane; float s = 0.f;
#pragma unroll
            for (int j = 0; j < 8; ++j) { const f32x4 v = xr[64 * j]; s += (v.x * v.x + v.y * v.y) + (v.z * v.z + v.w * v.w);
                *((GAS unsigned long long*)(XBA + (size_t)m * DM) + lane + 64 * j) = (unsigned long long)pk2(v.x, v.y) | ((unsigned long long)pk2(v.z, v.w) << 32); }
            s = wave_sum(s); if (lane < 32) ROWSS[(size_t)m * 32 + lane] = lane == 0 ? s : 0.f; }
        const float* p_in = INP(1); bf16* PB = WP(bf16, WS_PB);
        for (size_t i = gt; i < (size_t)DEPTH * T * PLE / 8; i += NGT) {
            const GAS f32x4* pp = (const GAS f32x4*)(p_in) + 2 * i; const f32x4 a = pp[0], b = pp[1];
            v4u o; o.x = pk2(a.x, a.y); o.y = pk2(a.z, a.w); o.z = pk2(b.x, b.y); o.w = pk2(b.z, b.w); *((GAS v4u*)PB + i) = o; }
    }
    SEAM(0);
    for (int l = 0; l < DEPTH; ++l) {
        const int p0 = 1 + 10 * l;
        if (EN(1) && IN(p0 + 0)) {
            GRIDV(); unsigned char* ws = WSB(); unsigned char* wl = ws + WS_W + (size_t)l * W_LAYER;
            pg8::Gemm g{WP(bf16, WS_XBA), (const bf16*)(wl + WO_W1), T, ZN, DM}; pg8::StaticOrder S; S.init(T, ZN, G, bx);
            pg8::EpiIn E{WP(bf16, WS_ZB), ZN, WP(bf16, WS_AGLU), WP(float, WS_RSP) + (size_t)(3 * l) * T * 32, 1.0f / DM, INP(17) + (size_t)l * NGATE, WP(float, WS_GA), INP(13) + l * MHD, INP(14) + l * MHD, (LAS float*)(L + XL_OFF), WP(bf16, WS_QKV), SEQ, (const LAS float*)(L + RT_OFF), (const LAS int*)(L + SLOT_OFF)};
            { const float* part = WP(float, WS_RSP) + (size_t)(3 * l) * T * 32; auto pre = [&]() { RSTD_TABLE(S, part, 49152); };
              pg8::gemm_phase<pg8::EpiIn, pg8::StaticOrder, true, true, decltype(pre)>(L + RING_OFF, g, S, E, pre); }
        }
        SEAM(p0 + 0);
        if (EN(2) && IN(p0 + 1)) {
            GRIDV(); unsigned char* ws = WSB(); bf16* ZB = WP(bf16, WS_ZB);
            { const float* cw = INP(4) + (size_t)l * CWID * CCH; const float* cb = INP(5) + l * CCH; const float* lg = INP(6) + l * CCH; const float* lb = INP(7) + l * CCH;
              for (int it = vcu; it < 256; it += G) conv_branch_item(it, WP(bf16, WS_AGLU), cw, cb, lg, lb, WP(bf16, WS_ACAT), (LAS float*)(L + RING_OFF), tid); }
            for (int it = vcu; it < 256; it += G) kmean_item(it, WP(bf16, WS_QKV), WP(float, WS_KMEAN), (LAS float*)(L + RING_OFF), tid);
            { const float* wa2 = INP(9) + (size_t)l * GRANK * GH * GDK; const float* ba = INP(10) + l * GH * GDK;
              int it = vcu;
              for (; it + G < 512; it += 2 * G) { GlaLocRegs R0, R1; gla_local_load(it, ZB, WP(float, WS_GA), R0, tid); gla_local_load(it + G, ZB, WP(float, WS_GA), R1, tid);
                  gla_local_compute(it, R0, wa2, ba, WP(bf16, WS_GQT), WP(float, WS_GINTRA), WP(float, WS_GDELTA), WP(float, WS_GDEC), L + RING_OFF, tid);
                  gla_local_compute(it + G, R1, wa2, ba, WP(bf16, WS_GQT), WP(float, WS_GINTRA), WP(float, WS_GDELTA), WP(float, WS_GDEC), L + RING_OFF, tid); }
              for (; it < 512; it += G) gla_local_item(it, ZB, WP(float, WS_GA), wa2, ba, WP(bf16, WS_GQT), WP(float, WS_GINTRA), WP(float, WS_GDELTA), WP(float, WS_GDEC), L + RING_OFF, tid); }
        }
        SEAM(p0 + 1);
        if (EN(3) && IN(p0 + 2)) {
            GRIDV(); unsigned char* ws = WSB();
#define GLA_SCAN_ALL() do { if (tid < 256) for (int g_ = vcu * 256 + tid; g_ < BATCH * GH * GDK * GDV; g_ += G * 256) gla_scan(g_, WP(float, WS_GDELTA), WP(float, WS_GDEC), WP(bf16, WS_GST)); } while (0)
            if (bx >= BATCH * MH * MNB) GLA_SCAN_ALL();
            for (int u = bx; u < BATCH * MH * MNB; u += G) {
                const int xg = u & 7, i = u >> 3, bh = (xg * 2 + (i >> 4)) & 15, t = i & 15, b = bh >> 3, h = bh & 7;
                const int sA = t + 1, jA = sA - 1, sB = 16 - t, jB = sB - 1;
                const bf16* qh = WP(bf16, WS_QKV) + (size_t)((0 * BATCH + b) * MH + h) * SEQ * MHD; const bf16* kh = WP(bf16, WS_QKV) + (size_t)((1 * BATCH + b) * MH + h) * SEQ * MHD; const bf16* vh = WP(bf16, WS_QKV) + (size_t)((2 * BATCH + b) * MH + h) * SEQ * MHD; const float* km = WP(float, WS_KMEAN) + (size_t)(b * MH + h) * MNB * MHD;
                moba::BlockRef pa{qh + (size_t)(jA * MBLK) * MHD, kh, vh,
                                  WP(bf16, WS_OMOBA) + (size_t)(b * SEQ + jA * MBLK) * (MH * MHD) + h * MHD, km, WP(float, WS_ML) + ((size_t)(b * SEQ + jA * MBLK) * 8 + h) * 2, jA, 0, 2 * sA};
                moba::BlockRef pb{qh + (size_t)(jB * MBLK) * MHD, kh, vh,
                                  WP(bf16, WS_OP1) + (size_t)(b * SEQ + jB * MBLK) * (MH * MHD) + h * MHD, km, WP(float, WS_ML) + ((size_t)T * 8 + (size_t)(b * SEQ + jB * MBLK) * 8 + h) * 2, jB, 2 * sB, 4 * sB};
                moba::Seam S;
                moba::moba_prime<MHD>(pa, (char*)lds + RING_OFF, S, [&]() { if (u == bx) GLA_SCAN_ALL(); });
                moba::moba_block<MHD, MH * MHD>(pa, pb, (char*)lds + RING_OFF, S);
                moba::moba_block<MHD, MH * MHD>(pb, pb, (char*)lds + RING_OFF, S);
            }
#undef GLA_SCAN_ALL
        }
        SEAM(p0 + 2);
        if (EN(4) && IN(p0 + 3)) {
            GRIDV(); unsigned char* ws = WSB();
            for (size_t i = (size_t)vcu * NTHR + tid; i < (size_t)T * MH * MHD / 8; i += (size_t)G * NTHR) moba_combine(i, WP(bf16, WS_OMOBA), WP(bf16, WS_OP1), WP(float, WS_ML), WP(bf16, WS_ACAT) + 1024);
            { const float* ng = INP(11) + l * GDV;
              int it = vcu;
              for (; it + G < 512; it += 2 * G) { GlaOutRegs R0, R1;
                  gla_out_load(it, WP(bf16, WS_ZB), WP(bf16, WS_GQT), WP(bf16, WS_GST), WP(float, WS_GINTRA), ng, R0, tid); gla_out_load(it + G, WP(bf16, WS_ZB), WP(bf16, WS_GQT), WP(bf16, WS_GST), WP(float, WS_GINTRA), ng, R1, tid);
                  gla_out_compute(it, R0, WP(bf16, WS_ACAT) + 512, (LAS float*)(L + RING_OFF), tid); gla_out_compute(it + G, R1, WP(bf16, WS_ACAT) + 512, (LAS float*)(L + RING_OFF), tid); }
              for (; it < 512; it += G) gla_out_item(it, WP(bf16, WS_ZB), WP(bf16, WS_GQT), WP(bf16, WS_GST), WP(float, WS_GINTRA), ng, WP(bf16, WS_ACAT) + 512, (LAS float*)(L + RING_OFF), tid); }
        }
        SEAM(p0 + 3);
        if (EN(5) && IN(p0 + 4)) {
            GRIDV(); unsigned char* ws = WSB(); unsigned char* wl = ws + WS_W + (size_t)l * W_LAYER;
            pg8::Gemm g{WP(bf16, WS_ACAT), (const bf16*)(wl + WO_CA), T, DM, DM}; pg8::StaticOrder S; S.init(T, DM, G, bx);
            pg8::EpiMerge3 E{(const unsigned char*)(ws + WS_G8), NGATE, 0, WP(bf16, WS_MRG), DM};
            static_assert(WS_G8 - WS_ZB == 580911104ull && NGATE == 6144, "EpiIn derives the u8 gate buffer from the zb pointer");
            pg8::gemm_phase<pg8::EpiMerge3, pg8::StaticOrder, true, true>(L + RING_OFF, g, S, E);
        }
        SEAM(p0 + 4);
        if (EN(7) && IN(p0 + 5)) {
            GRIDV(); unsigned char* ws = WSB(); unsigned char* wl = ws + WS_W + (size_t)l * W_LAYER; float* xres = OUTP();
            pg8::Gemm g{WP(bf16, WS_MRG), (const bf16*)(wl + WO_OU), T, DM, DM}; pg8::StaticOrder S; S.init(T, DM, G, bx);
            pg8::EpiRes<false> E{WP(bf16, WS_XBA), WP(bf16, WS_XBB), nullptr, WP(float, WS_RSP) + (size_t)(3 * l + 1) * T * 32, nullptr, 0.f, nullptr, DM};
            pg8::gemm_phase<pg8::EpiRes<false>, pg8::StaticOrder, true, true>(L + RING_OFF, g, S, E);
        }
        SEAM(p0 + 5);
        if (EN(8) && IN(p0 + 6)) {
            GRIDV(); unsigned char* ws = WSB(); unsigned char* wl = ws + WS_W + (size_t)l * W_LAYER;
            pg8::Gemm g{WP(bf16, WS_XBB), (const bf16*)(wl + WO_UP), T, FF2, DM}; pg8::StaticOrder S; S.init(T, FF2, G, bx);
            pg8::EpiFfn E{WP(bf16, WS_TMP), FF, INP(21) + (size_t)l * 3 * FF2, WP(float, WS_EDGE), (const LAS float*)(L + RT_OFF), (const LAS int*)(L + SLOT_OFF), (LAS float*)(L + XL_OFF)};
            RSTD_TABLE(S, WP(float, WS_RSP) + (size_t)(3 * l + 1) * T * 32, 0);
            pg8::gemm_phase<pg8::EpiFfn, pg8::StaticOrder, true, true>(L + RING_OFF, g, S, E);
        }
        if (EN(9) && IN(p0 + 6)) {
            GRIDV(); unsigned char* ws = WSB(); unsigned char* wl = ws + WS_W + (size_t)l * W_LAYER;
            int kple = PLE; asm volatile("" : "+s"(kple));
            pg8::Gemm g2{WP(bf16, WS_PB) + (size_t)l * T * PLE, (const bf16*)(wl + WO_PL), T, DM, kple}; pg8::TailOrder S2; S2.init(T, DM, G >= 256 ? 128 : 0, G >= 256 ? 2 : (256 + G - 1) / G, bx);
            pg8::EpiZ E2{WP(bf16, WS_PE), DM, nullptr, 0.f, nullptr, 1 << 30, 1 << 30, -1, nullptr};
            pg8::gemm_phase<pg8::EpiZ, pg8::TailOrder, true, true>(L + RING_OFF, g2, S2, E2);
        }
        SEAM(p0 + 6);
        if (EN(13) && IN(p0 + 8)) {
            GRIDV(); unsigned char* ws = WSB(); const float* fw = INP(21) + (size_t)l * 3 * FF2;
            pg8::StaticOrder S; S.init(T, DM, G, bx); pg8::Unit uu;
            for (int i = 0; S.next(i, uu); ++i) for (int s = tid; s < FF / 8; s += NTHR) ffn_fix_task(uu.pm * 4, s, WP(float, WS_EDGE), fw, WP(bf16, WS_TMP));
            asm volatile("s_waitcnt vmcnt(0)" ::: "memory"); __syncthreads();
        }
        if (EN(10) && IN(p0 + 8)) {
            GRIDV(); unsigned char* ws = WSB(); unsigned char* wl = ws + WS_W + (size_t)l * W_LAYER; float* xres = OUTP();
            pg8::Gemm g{WP(bf16, WS_TMP), (const bf16*)(wl + WO_DN), T, DM, FF}; pg8::StaticOrder S; S.init(T, DM, G, bx);
            pg8::EpiRes<false> E{WP(bf16, WS_XBB), WP(bf16, WS_XBC), nullptr, WP(float, WS_RSP) + (size_t)(3 * l + 2) * T * 32, nullptr, 0.f, nullptr, DM};
            pg8::gemm_phase<pg8::EpiRes<false>, pg8::StaticOrder, true, true>(L + RING_OFF, g, S, E);
        }
        SEAM(p0 + 8);
        if (EN(11) && IN(p0 + 9)) {
            GRIDV(); unsigned char* ws = WSB(); unsigned char* wl = ws + WS_W + (size_t)l * W_LAYER; float* xres = OUTP();
            pg8::Gemm g{WP(bf16, WS_XBC), (const bf16*)(wl + WO_PG), T, DM, DM}; pg8::StaticOrder S; S.init(T, DM, G, bx);
            pg8::EpiRes<true> E{WP(bf16, WS_XBC), WP(bf16, WS_XBA), l == DEPTH - 1 ? xres : nullptr, WP(float, WS_RSP) + (size_t)(3 * l + 3) * T * 32, WP(float, WS_RSP) + (size_t)(3 * l + 2) * T * 32, 1.0f / DM, WP(bf16, WS_PE), DM};
            pg8::gemm_phase<pg8::EpiRes<true>, pg8::StaticOrder, true, true>(L + RING_OFF, g, S, E);
        }
        SEAM(p0 + 9);
    }
#undef IN
#undef SEAM
}

extern "C" void kernel_launch(void* const* d_in, const int* in_sizes, int n_in, void* d_out, int out_size, void* d_ws, size_t ws_size, hipStream_t stream) {
    static int grid = 0;
    if (grid == 0) {
        if (n_in != 26 || out_size != T * DM || ws_size < WS_END) { fprintf(stderr, "kernel_launch: unexpected problem (n_in %d, out %d, ws %zu < %zu); nothing launched\n", n_in, out_size, ws_size, (size_t)WS_END); grid = -1; return; }
        int dev = 0, cus = 0, per_cu = 0;
        if (hipGetDevice(&dev) != hipSuccess || hipDeviceGetAttribute(&cus, hipDeviceAttributeMultiprocessorCount, dev) != hipSuccess) { grid = -1; return; }
        if (hipFuncSetAttribute((const void*)trunk_fwd, hipFuncAttributeMaxDynamicSharedMemorySize, LDS_BYTES) != hipSuccess) { fprintf(stderr, "kernel_launch: hipFuncSetAttribute failed\n"); grid = -1; return; }
        if (hipOccupancyMaxActiveBlocksPerMultiprocessor(&per_cu, (const void*)trunk_fwd, NTHR, LDS_BYTES) != hipSuccess || per_cu < 1) { fprintf(stderr, "kernel_launch: occupancy query says %d\n", per_cu); (void)hipGetLastError(); per_cu = 1; }
        grid = cus;
        if (grid > 256) grid = 256;
    }
    if (grid < 0) return;
    (void)hipMemsetAsync((char*)d_ws + WS_CTL, 0, CTL_ZERO_BYTES, stream);
    Args a{};
    for (int i = 0; i < 26; ++i) a.in[i] = (const float*)d_in[i];
    a.out = (float*)d_out; a.ws = (unsigned char*)d_ws; a.pad = 0;
#if MK_N_LAUNCHES == 1
    a.ph_lo = 0; a.ph_hi = N_PHASES; a.one = 1;
    hipLaunchKernelGGL(trunk_fwd, dim3(grid), dim3(NTHR), LDS_BYTES, stream, a);
#else
    for (int p = 0; p < N_PHASES; ++p) { a.ph_lo = p; a.ph_hi = p + 1; a.one = 0; hipLaunchKernelGGL(trunk_fwd, dim3(grid), dim3(NTHR), LDS_BYTES, stream, a); }
#endif
}
```
